# Optimizing an MI355X kernel written in HIP

```python
import math
import jax, jax.numpy as jnp
from jax import lax
import numpy as np

D_MODEL = 1024
BATCH = 2
SEQ = 8192
DEPTH = 2

HEAD_DIM = 64
N_Q_HEADS = 8
N_KV_HEADS = 2
GQA_GROUP = N_Q_HEADS // N_KV_HEADS
ATTN_WIDTH = N_Q_HEADS * HEAD_DIM
KV_WIDTH = N_KV_HEADS * HEAD_DIM
QKV_COLS = ATTN_WIDTH + 2 * KV_WIDTH
CONV_WIDTH = D_MODEL - ATTN_WIDTH
IN_COLS = QKV_COLS + 3 * CONV_WIDTH
D_FF = 2752
BLOCK = 128
WINDOW = 128
N_BUCKETS = 32
MAX_DISTANCE = 128
GRID_W = 64
ROPE_THETA = 10000.0
SHORT_K = 3
HYENA_EMB = 33
HYENA_FILTER_WIDTH = 64
HYENA_MIN_DECAY = math.log(1e-2) / 0.3
HYENA_MAX_DECAY = math.log(1e-2) / 1.5
EPS = 1e-6
NEG_INF = -1e30
N_EVEN = (DEPTH + 1) // 2
N_ODD = DEPTH // 2

kernel_name = 'hybrid_swa_shortconv_axialattn_hyena_macaron'


def rmsnorm(x, g):
    xf = x.astype(jnp.float32)
    y = xf * lax.rsqrt(jnp.mean(xf * xf, axis=-1, keepdims=True) + EPS)
    return (y * g.astype(jnp.float32)).astype(x.dtype)


def adaln_in(x, g, m, i):
    return rmsnorm(x, g) * (1 + m[:, i, 1][:, None]) + m[:, i, 0][:, None]


def swiglu(h, w1, w3, w2):
    return (jax.nn.silu(h @ w1) * (h @ w3)) @ w2


def short_conv(u, w, b):
    up = jnp.pad(u, ((0, 0), (1, 1), (0, 0)))
    return up[:, :-2] * w[0] + up[:, 1:-1] * w[1] + up[:, 2:] * w[2] + b


def t5_bucket(rel):
    half = N_BUCKETS // 2
    max_exact = half // 2
    n = jnp.abs(rel)
    large = max_exact + (jnp.log(jnp.maximum(n, 1).astype(jnp.float32) / max_exact)
                         / math.log(MAX_DISTANCE / max_exact) * (half - max_exact)).astype(jnp.int32)
    large = jnp.minimum(large, half - 1)
    return jnp.where(rel > 0, half, 0) + jnp.where(n < max_exact, n, large)


def split_qkv(h, qk_g):
    bsz, S, _ = h.shape
    q = h[..., :ATTN_WIDTH].reshape(bsz, S, N_Q_HEADS, HEAD_DIM)
    k = h[..., ATTN_WIDTH:ATTN_WIDTH + KV_WIDTH].reshape(bsz, S, N_KV_HEADS, HEAD_DIM)
    v = h[..., ATTN_WIDTH + KV_WIDTH:QKV_COLS].reshape(bsz, S, N_KV_HEADS, HEAD_DIM)
    return rmsnorm(q, qk_g[0]), rmsnorm(k, qk_g[1]), v


def windowed_attention(q, k, v, sink, rel_table):
    bsz, S = q.shape[0], q.shape[1]
    nb = S // BLOCK
    qb = q.reshape(bsz, nb, BLOCK, N_KV_HEADS, GQA_GROUP, HEAD_DIM)
    pad = ((0, 0), (BLOCK, BLOCK), (0, 0), (0, 0))
    kp = jnp.pad(k, pad).reshape(bsz, nb + 2, BLOCK, N_KV_HEADS, HEAD_DIM)
    vp = jnp.pad(v, pad).reshape(bsz, nb + 2, BLOCK, N_KV_HEADS, HEAD_DIM)
    kb = jnp.concatenate([kp[:, :-2], kp[:, 1:-1], kp[:, 2:]], axis=2)
    vb = jnp.concatenate([vp[:, :-2], vp[:, 1:-1], vp[:, 2:]], axis=2)
    s = jnp.einsum('bnqhgd,bnkhd->bnhgqk', qb, kb).astype(jnp.float32) * HEAD_DIM ** -0.5
    koff = jnp.arange(3 * BLOCK) - BLOCK
    rel = koff[None, :] - jnp.arange(BLOCK)[:, None]
    bias = rel_table.astype(jnp.float32)[t5_bucket(rel)]
    bias = jnp.transpose(bias, (2, 0, 1)).reshape(N_KV_HEADS, GQA_GROUP, BLOCK, 3 * BLOCK)
    kpos = jnp.arange(nb)[:, None] * BLOCK + koff[None, :]
    valid = (jnp.abs(rel) <= WINDOW)[None] & ((kpos >= 0) & (kpos < S))[:, None, :]
    s = jnp.where(valid[None, :, None, None], s + bias, NEG_INF)
    sk = sink.astype(jnp.float32).reshape(N_KV_HEADS, GQA_GROUP)[:, :, None, None]
    mx = jnp.maximum(jnp.max(s, axis=-1, keepdims=True), sk)
    p = jnp.exp(s - mx)
    den = jnp.sum(p, axis=-1, keepdims=True) + jnp.exp(sk - mx)
    o = jnp.einsum('bnhgqk,bnkhd->bnqhgd', (p / den).astype(v.dtype), vb)
    return o.reshape(bsz, S, ATTN_WIDTH)


def axial_rope(x):
    S = x.shape[1]
    rows = S // GRID_W
    row, col = jnp.meshgrid(jnp.arange(rows), jnp.arange(GRID_W), indexing='ij')
    row = row.reshape(-1).astype(jnp.float32)
    col = col.reshape(-1).astype(jnp.float32)
    half = HEAD_DIM // 2
    inv = ROPE_THETA ** (-jnp.arange(0, half, 2, dtype=jnp.float32) / half)
    ang = jnp.concatenate([row[:, None] * inv, col[:, None] * inv], axis=-1)
    cos = jnp.cos(ang)[None, :, None, :]
    sin = jnp.sin(ang)[None, :, None, :]
    xf = x.astype(jnp.float32)
    x1, x2 = xf[..., 0::2], xf[..., 1::2]
    out = jnp.stack([x1 * cos - x2 * sin, x1 * sin + x2 * cos], axis=-1).reshape(x.shape)
    return out.astype(x.dtype)


def blocked_dense_attention(q, k, v):
    bsz, S = q.shape[0], q.shape[1]
    nb = S // BLOCK
    qb = jnp.moveaxis(q.reshape(bsz, nb, BLOCK, N_KV_HEADS, GQA_GROUP, HEAD_DIM), 1, 0)
    scale = HEAD_DIM ** -0.5

    def attend(qblk):
        s = jnp.einsum('bqhgd,bkhd->bhgqk', qblk, k).astype(jnp.float32) * scale
        p = jax.nn.softmax(s, axis=-1).astype(v.dtype)
        return jnp.einsum('bhgqk,bkhd->bqhgd', p, v)

    o = lax.map(attend, qb)
    return jnp.moveaxis(o, 0, 1).reshape(bsz, S, ATTN_WIDTH)


def hyena_filter(L, w1, b1, w2, b2, w3, b3, w4, freq):
    f32 = jnp.float32
    t = jnp.linspace(0.0, 1.0, L, dtype=f32)[:, None]
    bands = (HYENA_EMB - 1) // 2
    w = (2.0 * math.pi / L) * jnp.arange(L, dtype=f32)[:, None]
    fr = jnp.linspace(1e-4, bands - 1, bands, dtype=f32)[None, :]
    z = jnp.concatenate([t, jnp.cos(fr * w), -jnp.sin(fr * w)], axis=-1)
    fq = freq.astype(f32)
    h = jnp.sin(fq * (z @ w1.astype(f32) + b1.astype(f32)))
    h = jnp.sin(fq * (h @ w2.astype(f32) + b2.astype(f32)))
    h = jnp.sin(fq * (h @ w3.astype(f32) + b3.astype(f32)))
    h = (h @ w4.astype(f32)).reshape(L, 2, CONV_WIDTH)
    deltas = jnp.abs(jnp.linspace(HYENA_MIN_DECAY, HYENA_MAX_DECAY, CONV_WIDTH, dtype=f32))
    h = h * jnp.exp(-t[:, :, None] * deltas)
    kfull = jnp.concatenate([h[:, 0], jnp.zeros((1, CONV_WIDTH), f32), h[:0:-1, 1]], axis=0)
    return kfull * lax.rsqrt(jnp.sum(kfull * kfull, axis=0, keepdims=True) + EPS)


def fft_long_conv(u, kfull):
    L = u.shape[1]
    uf = jnp.fft.rfft(u.astype(jnp.float32), n=2 * L, axis=1)
    kf = jnp.fft.rfft(kfull, n=2 * L, axis=0)
    return jnp.fft.irfft(uf * kf[None], n=2 * L, axis=1)[:, :L].astype(u.dtype)


def mixer_ab(h, qk_g, sink, conv_w, conv_b, rel_table):
    q, k, v = split_qkv(h, qk_g)
    att = windowed_attention(q, k, v, sink, rel_table)
    gb, gc, u = jnp.split(h[..., QKV_COLS:], 3, axis=-1)
    conv = gb * short_conv(gc * u, conv_w, conv_b)
    return jnp.concatenate([att, conv], axis=-1)


def mixer_cd(h, qk_g, conv_w, conv_b, f_w1, f_b1, f_w2, f_b2, f_w3, f_b3, f_w4, f_freq, skip):
    q, k, v = split_qkv(h, qk_g)
    att = blocked_dense_attention(axial_rope(q), axial_rope(k), v)
    u = short_conv(h[..., QKV_COLS:], conv_w, conv_b)
    x0, x1, vh = jnp.split(u, 3, axis=-1)
    kfull = hyena_filter(h.shape[1], f_w1, f_b1, f_w2, f_b2, f_w3, f_b3, f_w4, f_freq)
    z = x1 * vh
    y = x0 * (fft_long_conv(z, kfull) + skip * z)
    return jnp.concatenate([att, y], axis=-1)


def setup_inputs(seed: int = 0) -> dict:
    key = jax.random.key(seed)
    ks = iter(jax.random.split(key, 32))

    def nrm(shape, s):
        return s * jax.random.normal(next(ks), shape, jnp.float32)

    D = D_MODEL
    FW = HYENA_FILTER_WIDTH
    return {
        'x': nrm((BATCH, SEQ, D), 1.0),
        'c': nrm((BATCH, D), 1.0),
        'rel_table': nrm((N_BUCKETS, N_Q_HEADS), 0.5),
        'norm_g': 1.0 + nrm((DEPTH, 3, D), 0.02),
        'w_mod': nrm((DEPTH, D, 9 * D), 0.5 * D ** -0.5),
        'b_mod': nrm((DEPTH, 9 * D), 0.02),
        'w_in': nrm((DEPTH, D, IN_COLS), D ** -0.5),
        'w_out': nrm((DEPTH, D, D), D ** -0.5),
        'ffn_w1': nrm((DEPTH, 2, D, D_FF), D ** -0.5),
        'ffn_w3': nrm((DEPTH, 2, D, D_FF), D ** -0.5),
        'ffn_w2': nrm((DEPTH, 2, D_FF, D), D_FF ** -0.5),
        'a_qk_g': 1.0 + nrm((N_EVEN, 2, HEAD_DIM), 0.02),
        'a_sink': nrm((N_EVEN, N_Q_HEADS), 0.5),
        'b_conv_w': nrm((N_EVEN, SHORT_K, CONV_WIDTH), SHORT_K ** -0.5),
        'b_conv_b': nrm((N_EVEN, CONV_WIDTH), 0.02),
        'c_qk_g': 1.0 + nrm((N_ODD, 2, HEAD_DIM), 0.02),
        'd_conv_w': nrm((N_ODD, SHORT_K, 3 * CONV_WIDTH), SHORT_K ** -0.5),
        'd_conv_b': nrm((N_ODD, 3 * CONV_WIDTH), 0.02),
        'd_f_w1': nrm((N_ODD, HYENA_EMB, FW), HYENA_EMB ** -0.5),
        'd_f_b1': nrm((N_ODD, FW), 0.02),
        'd_f_w2': nrm((N_ODD, FW, FW), FW ** -0.5),
        'd_f_b2': nrm((N_ODD, FW), 0.02),
        'd_f_w3': nrm((N_ODD, FW, FW), FW ** -0.5),
        'd_f_b3': nrm((N_ODD, FW), 0.02),
        'd_f_w4': nrm((N_ODD, FW, 2 * CONV_WIDTH), FW ** -0.5),
        'd_f_freq': 1.0 + nrm((N_ODD, FW), 0.02),
        'd_skip': nrm((N_ODD, CONV_WIDTH), 0.1),
    }


def reference(x, c, rel_table, norm_g, w_mod, b_mod, w_in, w_out, ffn_w1, ffn_w3, ffn_w2,
              a_qk_g, a_sink, b_conv_w, b_conv_b, c_qk_g, d_conv_w, d_conv_b,
              d_f_w1, d_f_b1, d_f_w2, d_f_b2, d_f_w3, d_f_b3, d_f_w4, d_f_freq, d_skip):
    bsz = x.shape[0]
    cond = jax.nn.silu(c)
    for l in range(DEPTH):
        m = (cond @ w_mod[l] + b_mod[l]).reshape(bsz, 3, 3, D_MODEL)
        x = x + 0.5 * m[:, 0, 2][:, None] * swiglu(adaln_in(x, norm_g[l, 0], m, 0),
                                                   ffn_w1[l, 0], ffn_w3[l, 0], ffn_w2[l, 0])
        h = adaln_in(x, norm_g[l, 1], m, 1) @ w_in[l]
        j = l // 2
        if l % 2 == 0:
            mix = mixer_ab(h, a_qk_g[j], a_sink[j], b_conv_w[j], b_conv_b[j], rel_table)
        else:
            mix = mixer_cd(h, c_qk_g[j], d_conv_w[j], d_conv_b[j], d_f_w1[j], d_f_b1[j],
                           d_f_w2[j], d_f_b2[j], d_f_w3[j], d_f_b3[j], d_f_w4[j], d_f_freq[j], d_skip[j])
        x = x + m[:, 1, 2][:, None] * (mix @ w_out[l])
        x = x + 0.5 * m[:, 2, 2][:, None] * swiglu(adaln_in(x, norm_g[l, 2], m, 2),
                                                   ffn_w1[l, 1], ffn_w3[l, 1], ffn_w2[l, 1])
    return x
```

```cpp
#include <hip/hip_runtime.h>
#include <hip/hip_cooperative_groups.h>
#include <cstdio>
#include <cstdint>
#include <cmath>
#define MK_SINGLE 0
namespace pg8 {
#define PG8_LAS __attribute__((address_space(3)))
typedef unsigned short bf16_t;
typedef short bf16x8 __attribute__((ext_vector_type(8)));
typedef float f32x4 __attribute__((ext_vector_type(4)));
typedef unsigned u32x4 __attribute__((ext_vector_type(4)));
constexpr int BM = 256, BK = 64, HALF = 128, HTB = HALF * BK * 2  , STAGE_BYTES = 8 * HTB, NXCD = 8, WGM = 8;

__host__ __device__ __forceinline__ int lds_byte(int r, int c) { const int st = (r >> 4) * 2 + (c >> 5), rr = r & 15, cc = c & 31, ob = rr * 64 + cc * 2; return st * 1024 + (ob ^ (((ob >> 9) & 1) << 5)); }
__host__ __device__ __forceinline__ void stage_rc(int b, int& R, int& C) { const int st = b / 1024, sb = b % 1024, swz = sb ^ (((sb >> 9) & 1) << 5); R = (st >> 1) * 16 + swz / 64; C = (st & 1) * 32 + (swz % 64) / 2; }
__host__ __device__ __forceinline__ int perm32(int rho) { const int n = rho >> 4, i = rho & 15; return 8 * (i >> 2) + 4 * n + (i & 3); }

struct Unit { int pm, pn; };
struct Gemm { const bf16_t* A; const bf16_t* Bt; int M, N, K; };

struct StaticOrder {
    int nM, nN, nwg, G, c;
    __host__ __device__ void init(int M, int N, int G_, int c_) { nM = M / BM; nN = N / BM; nwg = nM * nN; G = G_; c = c_; }
    __host__ __device__ bool next(int i, Unit& u) const {
        const long L = (long)i * G + c; if (L >= nwg) return false;
        int wgid = (int)L; { const int q = nwg / NXCD, r = nwg % NXCD, xcd = wgid % NXCD, off = wgid / NXCD; wgid = (xcd < r ? xcd * (q + 1) : r * (q + 1) + (xcd - r) * q) + off; }
        const int nig = WGM * nN, gid = wgid / nig, fm = gid * WGM, gsz = (nM - fm) < WGM ? (nM - fm) : WGM;
        u.pm = fm + ((wgid % nig) % gsz); u.pn = (wgid % nig) / gsz; return true;
    }
    __device__ __forceinline__ void a_ready(const Unit&) const {}
    __device__ __forceinline__ void done(const Unit&) const {}
};

__device__ __forceinline__ unsigned cvt_pk_bf16(float lo, float hi) { unsigned r; asm volatile("v_cvt_pk_bf16_f32 %0, %1, %2" : "=v"(r) : "v"(lo), "v"(hi)); return r; }
typedef float f32x2 __attribute__((ext_vector_type(2)));
typedef float f32x2 __attribute__((ext_vector_type(2)));
__device__ __forceinline__ float silu_mul(float g, float u) { const float e = __builtin_amdgcn_exp2f(g * (-1.4426950408889634f)); return g * __builtin_amdgcn_rcpf(1.0f + e) * u; }
struct EpiBf16 {
    static constexpr bool PERM = true, AFTER_DRAIN = false;
    bf16_t* O; int ldc;
    __device__ __forceinline__ void operator()(const f32x4 (&acc)[2][2][4][2], const Unit& u, int wr, int wc, int fr, int fq) const {
        const int row0 = u.pm * BM + wr * 64 + fr; const int col0 = u.pn * BM + wc * 32 + 8 * fq;
#pragma unroll
        for (int ai = 0; ai < 2; ++ai)
#pragma unroll
            for (int m = 0; m < 4; ++m) { bf16_t* rowp = O + (size_t)(row0 + ai * HALF + m * 16) * ldc + col0;
#pragma unroll
                for (int bj = 0; bj < 2; ++bj) { const f32x4 v0 = acc[ai][bj][m][0], v1 = acc[ai][bj][m][1];
                    u32x4 w; w.x = cvt_pk_bf16(v0[0], v0[1]); w.y = cvt_pk_bf16(v0[2], v0[3]); w.z = cvt_pk_bf16(v1[0], v1[1]); w.w = cvt_pk_bf16(v1[2], v1[3]);
                    *(u32x4*)(rowp + bj * HALF) = w; } }
    }
};
struct EpiSwiglu {
    static constexpr bool PERM = true, AFTER_DRAIN = false;
    bf16_t* O; int ldc;
    __device__ __forceinline__ void operator()(const f32x4 (&acc)[2][2][4][2], const Unit& u, int wr, int wc, int fr, int fq) const {
        const int row0 = u.pm * BM + wr * 64 + fr; const int col0 = u.pn * HALF + wc * 32 + 8 * fq;
#pragma unroll
        for (int ai = 0; ai < 2; ++ai)
#pragma unroll
            for (int m = 0; m < 4; ++m) { bf16_t* rowp = O + (size_t)(row0 + ai * HALF + m * 16) * ldc + col0;
                const f32x4 g0 = acc[ai][0][m][0], g1 = acc[ai][0][m][1], u0 = acc[ai][1][m][0], u1 = acc[ai][1][m][1];
                u32x4 w; w.x = cvt_pk_bf16(silu_mul(g0[0], u0[0]), silu_mul(g0[1], u0[1])); w.y = cvt_pk_bf16(silu_mul(g0[2], u0[2]), silu_mul(g0[3], u0[3]));
                w.z = cvt_pk_bf16(silu_mul(g1[0], u1[0]), silu_mul(g1[1], u1[1])); w.w = cvt_pk_bf16(silu_mul(g1[2], u1[2]), silu_mul(g1[3], u1[3]));
                *(u32x4*)rowp = w; }
    }
};
struct EpiRes {
    static constexpr bool PERM = true, AFTER_DRAIN = false;
    const float* base; float* out; int ldc; const float* gate; int gstride; float gsc;
    __device__ __forceinline__ void operator()(const f32x4 (&acc)[2][2][4][2], const Unit& u, int wr, int wc, int fr, int fq) const {
        const int row0 = u.pm * BM + wr * 64 + fr; const int col0 = u.pn * BM + wc * 32 + 8 * fq;
        const float* gp = gate + (size_t)(u.pm >> 5) * gstride + col0;
        f32x4 gv[2][2];
#pragma unroll
        for (int bj = 0; bj < 2; ++bj)
#pragma unroll
            for (int n = 0; n < 2; ++n) gv[bj][n] = *(const f32x4*)(gp + bj * HALF + n * 4) * gsc;
#pragma unroll
        for (int ai = 0; ai < 2; ++ai)
#pragma unroll
            for (int m = 0; m < 4; ++m) { const size_t off = (size_t)(row0 + ai * HALF + m * 16) * ldc + col0;
#pragma unroll
                for (int bj = 0; bj < 2; ++bj)
#pragma unroll
                    for (int n = 0; n < 2; ++n) { const f32x4 bs = *(const f32x4*)(base + off + bj * HALF + n * 4); *(f32x4*)(out + off + bj * HALF + n * 4) = bs + gv[bj][n] * acc[ai][bj][m][n]; } }
    }
};
struct EpiAny {
    static constexpr bool PERM = true, AFTER_DRAIN = false;
    int kind; EpiBf16 eb; EpiSwiglu es; EpiRes er;
    __device__ __forceinline__ void operator()(const f32x4 (&acc)[2][2][4][2], const Unit& u, int wr, int wc, int fr, int fq) const {
        if (kind == 0) eb(acc, u, wr, wc, fr, fq); else if (kind == 1) es(acc, u, wr, wc, fr, fq); else er(acc, u, wr, wc, fr, fq);
    }
};

template <class Epi, class Sched, bool ALIGN_EPI = false, bool SP2 = false>
__device__ __forceinline__ void gemm_phase(PG8_LAS unsigned char* lds, const Gemm g, const Sched& S, const Epi& E) {
    int tid_ = threadIdx.x; asm volatile("" : "+v"(tid_));
    const int tid = tid_, wid = __builtin_amdgcn_readfirstlane(tid >> 6), lane = tid & 63, wr = wid >> 2, wc = wid & 3, fr = lane & 15, fq = lane >> 4;
    const int K = g.K, nt = K / BK;
    unsigned voffA[2], voffB[2];
#pragma unroll
    for (int i = 0; i < 2; ++i) { int R, C; stage_rc(tid * 16 + i * 8192, R, C); const int Rb = Epi::PERM ? ((R & ~31) + perm32(R & 31)) : R;
        voffA[i] = (unsigned)(R * K + C) * 2u; voffB[i] = (unsigned)(Rb * K + C) * 2u; }
    const size_t kstep = (size_t)(BK * 2);
    const size_t hstep = (size_t)HALF * K * 2;
    const size_t tstep = 2 * hstep;
    const unsigned ldsw = (unsigned)wid * 1024u;
    const int aoff = lds_byte(wr * 64 + fr, fq * 8), boff = lds_byte(wc * 32 + fr, fq * 8);
#define PG8_SA(b, h) (((b) * 2 + (h)) * HTB)
#define PG8_SB(b, h) ((4 + (b) * 2 + (h)) * HTB)
#define PG8_STAGE(bufoff, gbase, voff) do { _Pragma("unroll") for (int _i = 0; _i < 2; ++_i) \
        __builtin_amdgcn_global_load_lds((const unsigned*)((const char*)(gbase) + (voff)[_i]), (PG8_LAS unsigned*)(lds + (bufoff) + ldsw + _i * 8192), 16, 0, 0); } while (0)
#define PG8_LDA(dst, b, h) do { _Pragma("unroll") for (int m = 0; m < 4; ++m) _Pragma("unroll") for (int k = 0; k < 2; ++k) dst[m][k] = *(const PG8_LAS bf16x8*)(lds + PG8_SA(b, h) + aoff + m * 2048 + k * 1024); } while (0)
#define PG8_LDB(dst, b, h) do { _Pragma("unroll") for (int n = 0; n < 2; ++n) _Pragma("unroll") for (int k = 0; k < 2; ++k) dst[n][k] = *(const PG8_LAS bf16x8*)(lds + PG8_SB(b, h) + boff + n * 2048 + k * 1024); } while (0)
#define PG8_MMA(ai, bj, At, Bt) do { __builtin_amdgcn_s_setprio(1); _Pragma("unroll") for (int m = 0; m < 4; ++m) _Pragma("unroll") for (int n = 0; n < 2; ++n) _Pragma("unroll") for (int k = 0; k < 2; ++k) \
        acc[ai][bj][m][n] = __builtin_amdgcn_mfma_f32_16x16x32_bf16(Bt[n][k], At[m][k], acc[ai][bj][m][n], 0, 0, 0); __builtin_amdgcn_s_setprio(0); } while (0)
#define PG8_WAIT_V(n) asm volatile("s_waitcnt vmcnt(" #n ")" ::: "memory")
#define PG8_WAIT_L(n) asm volatile("s_waitcnt lgkmcnt(" #n ")" ::: "memory")
#define PG8_BAR __builtin_amdgcn_s_barrier()
#define PG8_SCHED __builtin_amdgcn_sched_barrier(0)
    Unit cur, nxt; int ui = 0;
    if (!S.next(0, cur)) return;
    f32x4 acc[2][2][4][2];
#pragma unroll
    for (int a = 0; a < 2; ++a)
#pragma unroll
        for (int b = 0; b < 2; ++b)
#pragma unroll
            for (int m = 0; m < 4; ++m)
#pragma unroll
                for (int n = 0; n < 2; ++n) acc[a][b][m][n] = (f32x4){0.f, 0.f, 0.f, 0.f};
    bf16x8 At[4][2], B0[2][2], B1[2][2];
    const char* cA = (const char*)g.A + (size_t)cur.pm * tstep; const char* cB = (const char*)g.Bt + (size_t)cur.pn * tstep;
    S.a_ready(cur);
    if constexpr (SP2) {
        PG8_STAGE(PG8_SB(0, 0), cB, voffB); PG8_STAGE(PG8_SB(0, 1), cB + hstep, voffB); PG8_STAGE(PG8_SA(0, 0), cA, voffA); PG8_STAGE(PG8_SA(0, 1), cA + hstep, voffA);
        if (wr == 1) PG8_BAR;
        PG8_WAIT_V(2); PG8_BAR;
        PG8_STAGE(PG8_SB(1, 0), cB + kstep, voffB); PG8_STAGE(PG8_SA(1, 0), cA + kstep, voffA); PG8_STAGE(PG8_SB(1, 1), cB + hstep + kstep, voffB);
        PG8_WAIT_V(6); PG8_BAR;
    } else {
        PG8_STAGE(PG8_SB(0, 0), cB, voffB); PG8_STAGE(PG8_SA(0, 0), cA, voffA); PG8_STAGE(PG8_SB(0, 1), cB + hstep, voffB); PG8_STAGE(PG8_SA(0, 1), cA + hstep, voffA);
        if (wr == 1) PG8_BAR;
        PG8_WAIT_V(4); PG8_BAR;
        PG8_STAGE(PG8_SB(1, 0), cB + kstep, voffB); PG8_STAGE(PG8_SA(1, 0), cA + kstep, voffA); PG8_STAGE(PG8_SB(1, 1), cB + hstep + kstep, voffB);
        PG8_WAIT_V(6); PG8_BAR;
    }
    for (;;) {
        const bool has_next = S.next(ui + 1, nxt);
        const char* nA = has_next ? (const char*)g.A + (size_t)nxt.pm * tstep : cA; const char* nB = has_next ? (const char*)g.Bt + (size_t)nxt.pn * tstep : cB;
        for (int t = 0; t < nt; t += 2) {
            const bool last = (t == nt - 2);
            const char* a1 = cA + (size_t)(t + 1) * kstep;
            const char* a2 = last ? nA : cA + (size_t)(t + 2) * kstep; const char* b2 = last ? nB : cB + (size_t)(t + 2) * kstep;
            const char* a3 = a2 + kstep; const char* b3 = b2 + kstep;
            if (last && has_next) S.a_ready(nxt);
            if constexpr (SP2) {
            PG8_LDB(B0, 0, 0); PG8_LDB(B1, 0, 1); PG8_SCHED; PG8_LDA(At, 0, 0); PG8_STAGE(PG8_SA(1, 1), a1 + hstep, voffA);
            PG8_WAIT_V(8); PG8_WAIT_L(0); PG8_BAR; PG8_MMA(0, 0, At, B0); PG8_MMA(0, 1, At, B1); PG8_BAR; PG8_SCHED;
            PG8_LDA(At, 0, 1); PG8_STAGE(PG8_SB(0, 0), b2, voffB); PG8_STAGE(PG8_SB(0, 1), b2 + hstep, voffB); PG8_STAGE(PG8_SA(0, 0), a2, voffA);
            PG8_WAIT_V(8); PG8_WAIT_L(0); PG8_BAR; PG8_MMA(1, 0, At, B0); PG8_MMA(1, 1, At, B1); PG8_BAR; PG8_SCHED;
            PG8_LDB(B0, 1, 0); PG8_LDB(B1, 1, 1); PG8_SCHED; PG8_LDA(At, 1, 0); PG8_STAGE(PG8_SA(0, 1), a2 + hstep, voffA);
            PG8_WAIT_V(8); PG8_WAIT_L(0); PG8_BAR; PG8_MMA(0, 0, At, B0); PG8_MMA(0, 1, At, B1); PG8_BAR; PG8_SCHED;
            PG8_LDA(At, 1, 1); PG8_STAGE(PG8_SB(1, 0), b3, voffB); PG8_STAGE(PG8_SB(1, 1), b3 + hstep, voffB); PG8_STAGE(PG8_SA(1, 0), a3, voffA);
            PG8_WAIT_V(8); PG8_WAIT_L(0); PG8_BAR; PG8_MMA(1, 0, At, B0); PG8_MMA(1, 1, At, B1); PG8_BAR; PG8_SCHED;
            } else {
            PG8_LDB(B0, 0, 0); PG8_SCHED; PG8_LDA(At, 0, 0); PG8_STAGE(PG8_SA(1, 1), a1 + hstep, voffA);
            PG8_WAIT_L(8); PG8_BAR; PG8_WAIT_L(0); PG8_MMA(0, 0, At, B0); PG8_BAR; PG8_SCHED;
            PG8_LDB(B1, 0, 1); PG8_STAGE(PG8_SB(0, 0), b2, voffB);
            PG8_BAR; PG8_WAIT_L(0); PG8_MMA(0, 1, At, B1); PG8_BAR;
            PG8_LDA(At, 0, 1); PG8_STAGE(PG8_SA(0, 0), a2, voffA);
            PG8_BAR; PG8_WAIT_L(0); PG8_MMA(1, 0, At, B0); PG8_BAR; PG8_SCHED;
            PG8_STAGE(PG8_SB(0, 1), b2 + hstep, voffB);
            PG8_WAIT_V(6); PG8_BAR; PG8_MMA(1, 1, At, B1); PG8_BAR;
            PG8_LDB(B0, 1, 0); PG8_SCHED; PG8_LDA(At, 1, 0); PG8_STAGE(PG8_SA(0, 1), a2 + hstep, voffA);
            PG8_WAIT_L(8); PG8_BAR; PG8_WAIT_L(0); PG8_MMA(0, 0, At, B0); PG8_BAR; PG8_SCHED;
            PG8_LDB(B1, 1, 1); PG8_STAGE(PG8_SB(1, 0), b3, voffB);
            PG8_BAR; PG8_WAIT_L(0); PG8_MMA(0, 1, At, B1); PG8_BAR;
            PG8_LDA(At, 1, 1); PG8_STAGE(PG8_SA(1, 0), a3, voffA);
            PG8_BAR; PG8_WAIT_L(0); PG8_MMA(1, 0, At, B0); PG8_BAR; PG8_SCHED;
            PG8_STAGE(PG8_SB(1, 1), b3 + hstep, voffB);
            PG8_WAIT_V(6); PG8_BAR; PG8_MMA(1, 1, At, B1); PG8_BAR;
            }
        }
        if constexpr (ALIGN_EPI) { if (wr == 0) PG8_BAR; }
        if constexpr (!Epi::AFTER_DRAIN) { E(acc, cur, wr, wc, fr, fq); S.done(cur); }
        if (!has_next) break;
#pragma unroll
        for (int a = 0; a < 2; ++a)
#pragma unroll
            for (int b = 0; b < 2; ++b)
#pragma unroll
                for (int m = 0; m < 4; ++m)
#pragma unroll
                    for (int n = 0; n < 2; ++n) acc[a][b][m][n] = (f32x4){0.f, 0.f, 0.f, 0.f};
        cur = nxt; cA = nA; cB = nB; ++ui;
        if constexpr (ALIGN_EPI) { if (wr == 1) PG8_BAR; }
    }
    PG8_WAIT_V(0);
    if constexpr (!ALIGN_EPI) { if (wr == 0) PG8_BAR; }
    PG8_BAR;
    if constexpr (Epi::AFTER_DRAIN) { E.fused(acc, cur, wr, wc, fr, fq, lds, wid, lane); S.done(cur); }
#undef PG8_SA
#undef PG8_SB
#undef PG8_STAGE
#undef PG8_LDA
#undef PG8_LDB
#undef PG8_MMA
#undef PG8_WAIT_V
#undef PG8_WAIT_L
#undef PG8_BAR
#undef PG8_SCHED
}
}
namespace att {
using bf16_t = unsigned short;
using bf16x8 = __attribute__((ext_vector_type(8))) short;
using s16x4 = __attribute__((ext_vector_type(4))) short;
using f32x16 = __attribute__((ext_vector_type(16))) float;
using u32x4 = __attribute__((ext_vector_type(4))) unsigned;
typedef __attribute__((address_space(3))) const char* lds_cptr;
typedef __attribute__((address_space(3))) char* lds_ptr;
typedef __attribute__((address_space(3))) float LDSF;
typedef __attribute__((address_space(3))) unsigned short LDSH;
constexpr int SEQ = 8192, QP = 512, KP = 128, VP = 2304, OP = 1024;
constexpr int SLOTB = 8192;
constexpr int L_K = 0, L_V = 2 * SLOTB, L_WS = 4 * SLOTB, L_OST = L_WS + 8 * 64 * 4, L_LUT = L_OST + 8 * 4096, L_END = L_LUT + 768 * 4;
constexpr float LOG2E = 1.4426950408889634f;
constexpr float C2 = 0.125f * LOG2E;
__device__ __forceinline__ int crow(int r, int hi) { return (r & 3) + 8 * (r >> 2) + 4 * hi; }
__device__ __forceinline__ void glds16(const void* gsrc, unsigned lds_dst) { unsigned keep;
  asm volatile("s_mov_b32 %0, m0\n\ts_mov_b32 m0, %2\n\ts_nop 0\n\tglobal_load_lds_dwordx4 %1, off\n\ts_mov_b32 m0, %0" : "=&s"(keep) : "v"(gsrc), "s"(lds_dst) : "memory"); }
typedef float f32x2_t __attribute__((ext_vector_type(2))); typedef __bf16 bf16x2_t __attribute__((ext_vector_type(2)));
__device__ __forceinline__ unsigned cvtpk_s(float lo, float hi) { f32x2_t v = {lo, hi}; bf16x2_t b = __builtin_convertvector(v, bf16x2_t); return __builtin_bit_cast(unsigned, b); }
__device__ __forceinline__ unsigned short f2bf1(float f) { return (unsigned short)(cvtpk_s(f, 0.f) & 0xffffu); }
#define ATT_WAIT_BAR(N) asm volatile("s_waitcnt vmcnt(" #N ") lgkmcnt(0)\n\ts_barrier" ::: "memory")
#define ATT_SBAR() __builtin_amdgcn_sched_barrier(0)
__device__ __forceinline__ void qkt(f32x16& p0, f32x16& p1, lds_cptr kb, const bf16x8* qr) {
  const f32x16 z = {};
#pragma unroll
  for (int d0 = 0; d0 < 4; ++d0) {
    const bf16x8 b0 = *(const __attribute__((address_space(3))) bf16x8*)(kb + d0 * 2048);
    const bf16x8 b1 = *(const __attribute__((address_space(3))) bf16x8*)(kb + d0 * 2048 + 512);
    if (d0 == 0) { p0 = __builtin_amdgcn_mfma_f32_32x32x16_bf16(b0, qr[0], z, 0, 0, 0); p1 = __builtin_amdgcn_mfma_f32_32x32x16_bf16(b1, qr[0], z, 0, 0, 0); }
    else { p0 = __builtin_amdgcn_mfma_f32_32x32x16_bf16(b0, qr[d0], p0, 0, 0, 0); p1 = __builtin_amdgcn_mfma_f32_32x32x16_bf16(b1, qr[d0], p1, 0, 0, 0); } }
}
__device__ __forceinline__ void pv(f32x16* o, int vb, bf16x8 pa0, bf16x8 pa1, bf16x8 pa2, bf16x8 pa3) {
#pragma unroll
  for (int d0 = 0; d0 < 2; ++d0) { s16x4 lo[4], hi[4];
#pragma unroll
    for (int ks = 0; ks < 4; ++ks) {
      asm volatile("ds_read_b64_tr_b16 %0,%1 offset:%c2" : "=&v"(lo[ks]) : "v"(vb), "i"(d0 * 4096 + ks * 1024) : "memory");
      asm volatile("ds_read_b64_tr_b16 %0,%1 offset:%c2" : "=&v"(hi[ks]) : "v"(vb), "i"(d0 * 4096 + ks * 1024 + 512) : "memory"); }
    asm volatile("s_waitcnt lgkmcnt(0)" ::: "memory"); ATT_SBAR();
#define ATT_PK(k) (bf16x8){lo[k][0], lo[k][1], lo[k][2], lo[k][3], hi[k][0], hi[k][1], hi[k][2], hi[k][3]}
    o[d0] = __builtin_amdgcn_mfma_f32_32x32x16_bf16(pa0, ATT_PK(0), o[d0], 0, 0, 0);
    o[d0] = __builtin_amdgcn_mfma_f32_32x32x16_bf16(pa1, ATT_PK(1), o[d0], 0, 0, 0);
    o[d0] = __builtin_amdgcn_mfma_f32_32x32x16_bf16(pa2, ATT_PK(2), o[d0], 0, 0, 0);
    o[d0] = __builtin_amdgcn_mfma_f32_32x32x16_bf16(pa3, ATT_PK(3), o[d0], 0, 0, 0);
#undef ATT_PK
  }
}
__device__ __forceinline__ int t5_bucket(int rel) {
  const int n = rel < 0 ? -rel : rel;
  const int large = n < 12 ? 8 : n < 16 ? 9 : n < 23 ? 10 : n < 32 ? 11 : n < 46 ? 12 : n < 64 ? 13 : n < 91 ? 14 : 15;
  return (rel > 0 ? 16 : 0) + (n < 8 ? n : large);
}
__device__ __forceinline__ void attn_unit(const bool WIN, int b, int h, int qb, const bf16_t* Q, const bf16_t* __restrict__ K, const bf16_t* __restrict__ V, bf16_t* O, lds_ptr shm,
                                                               const float* rel_table, float sink2) {
  int tid_ = threadIdx.x; asm volatile("" : "+v"(tid_));
  const int tid = tid_, lane = tid & 63, r32 = lane & 31, hi = lane >> 5; const int wid = __builtin_amdgcn_readfirstlane(tid >> 6);
  const long rowbase = (long)b * SEQ; const int q0 = qb * 256; const int kvh = h >> 2;
  const unsigned lds0 = (unsigned)(uintptr_t)shm;
  LDSF* wsf = (LDSF*)(shm + L_WS) + wid * 64;
  LDSF* lut = (LDSF*)(shm + L_LUT);
  const bf16_t* Kh = K + rowbase * KP + kvh * 64; const bf16_t* Vh = V + rowbase * VP + kvh * 64;
  const bf16_t* ksrc = Kh + (long)lane * KP + wid * 8;
  const bf16_t* vsrc = Vh + (long)(16 * (wid & 3) + (lane >> 2)) * VP + (wid >> 2) * 32 + (lane & 3) * 8;
  const unsigned kdst = lds0 + L_K + wid * 1024, vdst = lds0 + L_V + wid * 1024;
#define ATT_DMA_K(t, slot) glds16(ksrc + (long)(t) * 64 * KP, (unsigned)__builtin_amdgcn_readfirstlane(kdst + (slot)))
#define ATT_DMA_V(t, slot) glds16(vsrc + (long)(t) * 64 * VP, (unsigned)__builtin_amdgcn_readfirstlane(vdst + (slot)))
  const int vb0 = (int)(lds0 + L_V) + ((lane >> 4) & 1) * 32 + (lane & 3) * 8 + (4 * hi + ((lane & 15) >> 2)) * 64;
  const lds_cptr shm3 = (lds_cptr)shm; const lds_cptr kp0 = shm3 + L_K + hi * 1024 + r32 * 16;
  int t_lo = 0, t_hi = SEQ / 64;
  if (WIN) { t_lo = q0 / 64 - 2; if (t_lo < 0) t_lo = 0; t_hi = q0 / 64 + 6; if (t_hi > SEQ / 64) t_hi = SEQ / 64; }
  ATT_DMA_K(t_lo, 0); ATT_DMA_V(t_lo, 0);
  if (WIN) { for (int i = tid; i < 768; i += 512) { const int rel = i - 384; const int n = rel < 0 ? -rel : rel; float v = -INFINITY; if (n <= 128) v = rel_table[t5_bucket(rel) * 8 + h] * LOG2E; lut[i] = v; } }
  const bf16_t* Qw = Q + (rowbase + q0 + wid * 32) * QP + h * 64;
  bf16x8 qr[4];
#pragma unroll
  for (int d0 = 0; d0 < 4; ++d0) qr[d0] = *reinterpret_cast<const bf16x8*>(&Qw[(long)r32 * QP + d0 * 16 + hi * 8]);
  float mhat = WIN ? sink2 : -1.0e30f, l_reg = (WIN && hi == 0) ? 1.f : 0.f; f32x16 o[2]; o[0] = f32x16{}; o[1] = f32x16{};
  const int qw = q0 + wid * 32;
  for (int t = t_lo; t < t_hi; ++t) {
    const int slot = ((t - t_lo) & 1) * SLOTB;
    if (t + 1 < t_hi) { ATT_DMA_K(t + 1, slot ^ SLOTB); ATT_DMA_V(t + 1, slot ^ SLOTB); ATT_WAIT_BAR(2); } else { ATT_WAIT_BAR(0); }
    const int tb = t * 64;
    const bool act = !WIN || !(tb > qw + 31 + 128 || tb + 63 < qw - 128);
    if (act) {
      f32x16 p0, p1; qkt(p0, p1, kp0 + slot, qr);
      if (WIN) { const int base = tb - (qw + r32) + 384 + 4 * hi;
#pragma unroll
        for (int r = 0; r < 16; ++r) { const int ix = base + (r & 3) + 8 * (r >> 2); p0[r] += lut[ix]; p1[r] += lut[ix + 32]; } }
      float m = p0[0];
#pragma unroll
      for (int r = 0; r < 16; ++r) { m = __builtin_fmaxf(m, p0[r]); m = __builtin_fmaxf(m, p1[r]); }
      { auto rr = __builtin_amdgcn_permlane32_swap(__float_as_uint(m), __float_as_uint(m), false, false); m = __builtin_fmaxf(__uint_as_float(rr[0]), __uint_as_float(rr[1])); }
      const float mnew = __builtin_fmaxf(mhat, m); const float f = __builtin_amdgcn_exp2f(mhat - mnew); mhat = mnew; l_reg *= f;
      if (hi == 0) wsf[r32] = f;
      float sacc = 0.f;
#pragma unroll
      for (int r = 0; r < 16; ++r) { p0[r] = __builtin_amdgcn_exp2f(p0[r] - mnew); p1[r] = __builtin_amdgcn_exp2f(p1[r] - mnew); sacc += p0[r] + p1[r]; }
      l_reg += sacc;
      const u32x4 pw0 = {cvtpk_s(p0[0], p0[1]), cvtpk_s(p0[2], p0[3]), cvtpk_s(p0[4], p0[5]), cvtpk_s(p0[6], p0[7])};
      const u32x4 pw1 = {cvtpk_s(p0[8], p0[9]), cvtpk_s(p0[10], p0[11]), cvtpk_s(p0[12], p0[13]), cvtpk_s(p0[14], p0[15])};
      const u32x4 pw2 = {cvtpk_s(p1[0], p1[1]), cvtpk_s(p1[2], p1[3]), cvtpk_s(p1[4], p1[5]), cvtpk_s(p1[6], p1[7])};
      const u32x4 pw3 = {cvtpk_s(p1[8], p1[9]), cvtpk_s(p1[10], p1[11]), cvtpk_s(p1[12], p1[13]), cvtpk_s(p1[14], p1[15])};
      asm volatile("s_waitcnt lgkmcnt(0)" ::: "memory");
#pragma unroll
      for (int r = 0; r < 16; ++r) { const float fr_ = wsf[crow(r, hi)]; o[0][r] *= fr_; o[1][r] *= fr_; }
      ATT_SBAR();
      pv(o, vb0 + slot, __builtin_bit_cast(bf16x8, pw0), __builtin_bit_cast(bf16x8, pw1), __builtin_bit_cast(bf16x8, pw2), __builtin_bit_cast(bf16x8, pw3));
    }
    asm volatile("s_waitcnt lgkmcnt(0)\n\ts_barrier" ::: "memory");
  }
  { auto rr = __builtin_amdgcn_permlane32_swap(__float_as_uint(l_reg), __float_as_uint(l_reg), false, false); l_reg = __uint_as_float(rr[0]) + __uint_as_float(rr[1]); }
  if (hi == 0) wsf[32 + r32] = l_reg; asm volatile("s_waitcnt lgkmcnt(0)" ::: "memory");
  float rli[16];
#pragma unroll
  for (int r = 0; r < 16; ++r) rli[r] = __builtin_amdgcn_rcpf(wsf[32 + crow(r, hi)]);
  bf16_t* Ow = O + (rowbase + q0 + wid * 32) * OP + h * 64;
  { LDSH* stg = (LDSH*)(shm + L_OST) + wid * 2048;
#pragma unroll
    for (int r = 0; r < 16; ++r) { const int orow = crow(r, hi);
#pragma unroll
      for (int d0 = 0; d0 < 2; ++d0) stg[orow * 64 + d0 * 32 + r32] = f2bf1(o[d0][r] * rli[r]); }
    asm volatile("s_waitcnt lgkmcnt(0)" ::: "memory");
#pragma unroll
    for (int i = 0; i < 4; ++i) { const int row = i * 8 + (lane >> 3), ch = lane & 7; const u32x4 v = *(const __attribute__((address_space(3))) u32x4*)(stg + row * 64 + ch * 8); *(u32x4*)(Ow + (long)row * OP + ch * 8) = v; } }
  asm volatile("s_waitcnt vmcnt(0) lgkmcnt(0)\n\ts_barrier" ::: "memory");
#undef ATT_DMA_K
#undef ATT_DMA_V
}
}
#define GAS __attribute__((address_space(1)))
#define LAS __attribute__((address_space(3)))
typedef unsigned short bf16;
typedef unsigned v4u __attribute__((ext_vector_type(4)));
typedef unsigned v2u __attribute__((ext_vector_type(2)));
typedef float f32x4 __attribute__((ext_vector_type(4)));
typedef float f32x2 __attribute__((ext_vector_type(2)));
constexpr int NWAVES = 8, NTHR = 512;
constexpr int BATCH = 2, SEQ = 8192, DMODEL = 1024, MTOK = BATCH * SEQ, DFF = 2752, DFFP = 2816, N13 = 5632, INCOLS = 2304, MODC = 9216;
constexpr float EPS = 1e-6f;
constexpr size_t MiB = 1u << 20;
constexpr size_t WS_CTL = 0, CTL_ZERO_BYTES = 1 * MiB;
constexpr size_t WS_MVEC = 512 * 1024;
constexpr size_t WS_H3 = 2 * MiB;
constexpr size_t WS_W13 = 4 * MiB, W13_STRIDE = 11 * MiB;
constexpr size_t WS_W2T = 26 * MiB, W2T_STRIDE = 11 * MiB / 2;
constexpr size_t WS_WIN = 37 * MiB;
constexpr size_t WS_WOUT = WS_WIN + 9 * MiB / 2;
constexpr size_t WS_XN = 44 * MiB;
constexpr size_t WS_HID = 76 * MiB;
constexpr size_t WS_QN = 148 * MiB;
constexpr size_t WS_KN = 164 * MiB;
constexpr size_t WS_ZT = 168 * MiB;
constexpr size_t WS_KF = 200 * MiB;
constexpr size_t WS_END = 264 * MiB;
static_assert(WS_WOUT + 2 * MiB <= WS_XN && WS_HID + (size_t)MTOK * DFFP * 2 == WS_KN && WS_HID + (size_t)MTOK * INCOLS * 2 == WS_QN, "ws map");
constexpr int CW_BAR = 4096;
constexpr int LDS_BYTES = 147456;
constexpr int SCR_BYTES = 139264;
constexpr int MISC_OFF = 143360;
#define LDS_WAIT() asm volatile("s_waitcnt lgkmcnt(0)" ::: "memory")
#define VM_WAIT() asm volatile("s_waitcnt vmcnt(0)" ::: "memory")
__device__ __forceinline__ float bf_lo(unsigned v) { return __uint_as_float(v << 16); }
__device__ __forceinline__ float bf_hi(unsigned v) { return __uint_as_float(v & 0xffff0000u); }
__device__ __forceinline__ float bf1(unsigned short v) { return __uint_as_float((unsigned)v << 16); }
__device__ __forceinline__ unsigned pk2(float lo, float hi) { return att::cvtpk_s(lo, hi); }
__device__ __forceinline__ float wave_sum(float v) {
#pragma unroll
    for (int o = 1; o < 64; o <<= 1) v += __shfl_xor(v, o);
    return v;
}
template <class T> __device__ __forceinline__ T* uni_ptr(T* p) { const unsigned long long v = (unsigned long long)p; const unsigned lo = __builtin_amdgcn_readfirstlane((unsigned)v), hi = __builtin_amdgcn_readfirstlane((unsigned)(v >> 32)); return (T*)(((unsigned long long)hi << 32) | lo); }
__device__ __forceinline__ int uni_i(int v) { return __builtin_amdgcn_readfirstlane(v); }
#define XB_TMO      128
#define XB_XCNT(j)  (256  + 64 * (j))
#define XB_XSUB(j)  (1280 + 64 * (j))
#define XB_XGEN(j)  (2304 + 64 * (j))
#define XB_TOP      3328
#define XB_TOPGEN   3392
#define XCD_BAR_WORDS 3456
#define XB_SPIN_CAP (1u << 18)

__device__ __forceinline__ unsigned xb_ld(unsigned* p)              { return __hip_atomic_load(p, __ATOMIC_RELAXED, __HIP_MEMORY_SCOPE_AGENT); }
__device__ __forceinline__ unsigned xb_add(unsigned* p, unsigned v) { return __hip_atomic_fetch_add(p, v, __ATOMIC_RELAXED, __HIP_MEMORY_SCOPE_AGENT); }
__device__ __forceinline__ unsigned xb_xcc_id() { return (unsigned)__builtin_amdgcn_s_getreg((3 << 11) | 20) & 0xFu; }
#define XB_SPIN(cond, bar) do { unsigned _sp = 0; while (cond) { __builtin_amdgcn_s_sleep(1); \
    if ((++_sp & 255u) == 0u) { if (xb_ld(&(bar)[XB_TMO])) break; if (_sp > XB_SPIN_CAP) { atomicAdd(&(bar)[XB_TMO], 1u); break; } } } } while (0)

struct XcdBarrier {
    unsigned* bar; unsigned x;
    volatile LAS unsigned* st;
};

__device__ __forceinline__ XcdBarrier xcd_barrier_post(unsigned* bar, volatile LAS unsigned* st) {
    XcdBarrier b; b.bar = bar; b.x = xb_xcc_id(); b.st = st;
    if (threadIdx.x == 0) (void)xb_add(&bar[XB_XCNT(b.x)], 1u);
    return b;
}
__device__ __forceinline__ void xcd_barrier_complete(unsigned* bar, unsigned x, unsigned& nloc, unsigned& nx) {
    const unsigned G = gridDim.x * gridDim.y * gridDim.z;
    unsigned sum, cnt, mine, sp = 0u;
    for (;;) {
        sum = 0u; cnt = 0u; mine = 0u;
#pragma unroll
        for (unsigned j = 0; j < 16; ++j) { const unsigned c = xb_ld(&bar[XB_XCNT(j)]); sum += c; cnt += (c > 0u) ? 1u : 0u; mine = (j == x) ? c : mine; }
        if (sum == G) break;
        __builtin_amdgcn_s_sleep(1);
        if ((++sp & 255u) == 0u) { if (xb_ld(&bar[XB_TMO])) break; if (sp > XB_SPIN_CAP) { atomicAdd(&bar[XB_TMO], 1u); break; } }
    }
    nloc = mine > 0u ? mine : 1u; nx = cnt > 0u ? cnt : 1u;
}

__device__ __forceinline__ void xcd_barrier(const XcdBarrier& b) {
    asm volatile("s_waitcnt vmcnt(0)" ::: "memory");
    __syncthreads();
    if (threadIdx.x == 0) {
        unsigned* bar = b.bar;
        __builtin_amdgcn_s_waitcnt(0);
        unsigned nloc = b.st[0], nx = b.st[1];
        if (nloc == 0u) { xcd_barrier_complete(bar, b.x, nloc, nx); b.st[0] = nloc; b.st[1] = nx; }
        const unsigned old = xb_add(&bar[XB_XSUB(b.x)], 1u);
        const unsigned gen = old / nloc;
        if (old + 1u == (gen + 1u) * nloc) {
            __builtin_amdgcn_fence(__ATOMIC_RELEASE, "agent");
            asm volatile("s_waitcnt vmcnt(0)" ::: "memory");
            const unsigned og = xb_add(&bar[XB_TOP], 1u);
            const unsigned tg = og / nx;
            if (og + 1u == (tg + 1u) * nx) xb_add(&bar[XB_TOPGEN], 1u);
            else XB_SPIN(xb_ld(&bar[XB_TOPGEN]) == tg, bar);
            __builtin_amdgcn_fence(__ATOMIC_ACQUIRE, "agent");
            xb_add(&bar[XB_XGEN(b.x)], 1u);
            asm volatile("s_waitcnt vmcnt(0)" ::: "memory");
        } else {
            XB_SPIN(xb_ld(&bar[XB_XGEN(b.x)]) == gen, bar);
            __builtin_amdgcn_fence(__ATOMIC_ACQUIRE, "agent");
            asm volatile("s_waitcnt vmcnt(0)" ::: "memory");
        }
    }
    __syncthreads();
}
struct Args { const float* in[27]; float* out; unsigned char* ws; int ph_lo, ph_hi, use_cg, pad; };
struct Ctx {
    LAS unsigned char* lds; int tid, lane, wave, vcu, G;
    float* out; unsigned char* ws;
};
__device__ __forceinline__ void transpose_item(const float* W, int N, int k0, int n0src, bool valid, bf16* WT, size_t drow0, int Kd, LAS float* scr, int lane) {
    if (valid) {
#pragma unroll 8
        for (int i = 0; i < 32; ++i) { const int kk = 2 * i + (lane >> 5); scr[kk * 33 + (lane & 31)] = W[(size_t)(k0 + kk) * N + n0src + (lane & 31)]; }
    } else {
#pragma unroll 8
        for (int i = 0; i < 32; ++i) { const int kk = 2 * i + (lane >> 5); scr[kk * 33 + (lane & 31)] = 0.f; }
    }
    LDS_WAIT(); asm volatile("" ::: "memory");
    const int c = lane & 7;
#pragma unroll
    for (int j = 0; j < 4; ++j) { const int n = (lane >> 3) + 8 * j; const LAS float* s = scr + (8 * c) * 33 + n;
        v4u o; o.x = pk2(s[0 * 33], s[1 * 33]); o.y = pk2(s[2 * 33], s[3 * 33]); o.z = pk2(s[4 * 33], s[5 * 33]); o.w = pk2(s[6 * 33], s[7 * 33]);
        *(v4u*)(WT + (drow0 + n) * (size_t)Kd + k0 + 8 * c) = o; }
    LDS_WAIT(); asm volatile("" ::: "memory");
}
__device__ __forceinline__ void convert_weights(const Ctx& F, const Args& A, int l) {
    LAS float* scr = (LAS float*)(F.lds + F.wave * 16384);
    const int gw = F.vcu * NWAVES + F.wave, NGW = F.G * NWAVES;
    constexpr int I13 = 16 * 176, I2 = 44 * 32, IIN = 16 * 72, IOUT = 16 * 32, NIT = 2 * I13 + 2 * I2 + IIN + IOUT;
    for (int it = gw; it < NIT; it += NGW) {
        int r = it;
        if (r < 2 * I13) { const int f = r / I13; r -= f * I13; const int kb = r / 176, nb = r % 176, np = 32 * nb, pn = np >> 8, bj = (np >> 7) & 1, j0 = np & 127, sc = 128 * pn + j0;
            const float* src = (bj ? A.in[9] : A.in[8]) + (size_t)(l * 2 + f) * DMODEL * DFF;
            transpose_item(src, DFF, 64 * kb, sc, sc < DFF, (bf16*)(F.ws + WS_W13 + f * W13_STRIDE), (size_t)np, DMODEL, scr, F.lane); continue; }
        r -= 2 * I13;
        if (r < 2 * I2) { const int f = r / I2; r -= f * I2; const int kb = r / 32, nb = r % 32;
            const float* src = A.in[10] + (size_t)(l * 2 + f) * DFF * DMODEL;
            transpose_item(src, DMODEL, 64 * kb, 32 * nb, 64 * kb < DFF, (bf16*)(F.ws + WS_W2T + f * W2T_STRIDE), (size_t)(32 * nb), DFFP, scr, F.lane); continue; }
        r -= 2 * I2;
        if (r < IIN) { const int kb = r / 72, nb = r % 72; transpose_item(A.in[6] + (size_t)l * DMODEL * INCOLS, INCOLS, 64 * kb, 32 * nb, true, (bf16*)(F.ws + WS_WIN), (size_t)(32 * nb), DMODEL, scr, F.lane); continue; }
        r -= IIN;
        { const int kb = r / 32, nb = r % 32; transpose_item(A.in[7] + (size_t)l * DMODEL * DMODEL, DMODEL, 64 * kb, 32 * nb, true, (bf16*)(F.ws + WS_WOUT), (size_t)(32 * nb), DMODEL, scr, F.lane); }
    }
}
__device__ __forceinline__ void mod_gemv(const Ctx& F, const Args& A) {
    const int gw = F.vcu * NWAVES + F.wave, NGW = F.G * NWAVES;
    const float* c = A.in[1]; const float* wm = A.in[4]; const float* bm = A.in[5]; float* mv = (float*)(F.ws + WS_MVEC);
    for (int it = gw; it < 576; it += NGW) {
        const int l = it / 288, rem = it % 288, nc = rem >> 3, kc = rem & 7; const int n0 = nc * 256 + 4 * F.lane;
        f32x4 a0 = {0.f, 0.f, 0.f, 0.f}, a1 = {0.f, 0.f, 0.f, 0.f};
        const float* wp = wm + ((size_t)l * DMODEL + kc * 128) * MODC + n0;
#pragma unroll 4
        for (int k = 0; k < 128; ++k) { const f32x4 w = *(const f32x4*)(wp + (size_t)k * MODC);
            const float c0 = c[kc * 128 + k], c1 = c[DMODEL + kc * 128 + k];
            const float s0 = c0 / (1.f + __expf(-c0)), s1 = c1 / (1.f + __expf(-c1));
            a0 += w * s0; a1 += w * s1; }
        if (kc == 0) { const f32x4 bv = *(const f32x4*)(bm + (size_t)l * MODC + n0); a0 += bv; a1 += bv; }
        float* d0 = mv + (size_t)(l * 2 + 0) * MODC + n0; float* d1 = mv + (size_t)(l * 2 + 1) * MODC + n0;
#pragma unroll
        for (int e = 0; e < 4; ++e) { unsafeAtomicAdd(d0 + e, a0[e]); unsafeAtomicAdd(d1 + e, a1[e]); }
    }
}
__device__ __forceinline__ void hyena_h3(const Ctx& F, const Args& A) {
    const int gw = F.vcu * NWAVES + F.wave, NGW = F.G * NWAVES; const int j = F.lane;
    const float* w1 = A.in[18]; const float* b1 = A.in[19]; const float* w2 = A.in[20]; const float* b2 = A.in[21]; const float* w3 = A.in[22]; const float* b3 = A.in[23]; const float* fqp = A.in[25];
    float* H3 = (float*)(F.ws + WS_H3);
    const float fq = fqp[j], bb1 = b1[j], bb2 = b2[j], bb3 = b3[j];
    const int fi = (j >= 1 && j <= 32) ? ((j - 1) & 15) : 0; const float fr = 1e-4f + (float)fi * ((15.0f - 1e-4f) / 15.0f);
    for (int l = gw; l < SEQ; l += NGW) {
        const float t = (float)l * (1.0f / 8191.0f); const float w = (float)l * (float)(6.283185307179586 / 8192.0);
        const float arg = fr * w;
        float zv = (j == 0) ? t : (j <= 16 ? cosf(arg) : -sinf(arg));
        float a = bb1;
#pragma unroll
        for (int i = 0; i < 33; ++i) a += __shfl(zv, i) * w1[i * 64 + j];
        const float h1 = sinf(fq * a);
        a = bb2;
#pragma unroll 16
        for (int i = 0; i < 64; ++i) a += __shfl(h1, i) * w2[i * 64 + j];
        const float h2 = sinf(fq * a);
        a = bb3;
#pragma unroll 16
        for (int i = 0; i < 64; ++i) a += __shfl(h2, i) * w3[i * 64 + j];
        H3[(size_t)l * 64 + j] = sinf(fq * a);
    }
}
__device__ __forceinline__ void norm_phase(const Ctx& F, const Args& A, int l, int i) {
    const int gw = F.vcu * NWAVES + F.wave, NGW = F.G * NWAVES;
    const float* xin = (l == 0 && i == 0) ? A.in[0] : F.out; const float* g = A.in[3] + (size_t)(l * 3 + i) * DMODEL; const float* mv = (const float*)(F.ws + WS_MVEC);
    bf16* XN = (bf16*)(F.ws + WS_XN);
    for (int row = gw; row < MTOK; row += NGW) {
        const int b = row >> 13; const float* sh = mv + (size_t)(l * 2 + b) * MODC + i * 3072; const float* sc = sh + 1024;
        const f32x4* xr = (const f32x4*)(xin + (size_t)row * DMODEL) + F.lane;
        f32x4 v[4]; float s = 0.f;
#pragma unroll
        for (int j = 0; j < 4; ++j) { v[j] = xr[64 * j]; s += (v[j].x * v[j].x + v[j].y * v[j].y) + (v[j].z * v[j].z + v[j].w * v[j].w); }
        const float rstd = rsqrtf(wave_sum(s) * (1.f / DMODEL) + EPS);
        v2u* o8 = (v2u*)(XN + (size_t)row * DMODEL) + F.lane;
#pragma unroll
        for (int j = 0; j < 4; ++j) { const f32x4 gg = ((const f32x4*)g)[64 * j + F.lane], ss = ((const f32x4*)sc)[64 * j + F.lane], hh = ((const f32x4*)sh)[64 * j + F.lane];
            const f32x4 y = v[j] * rstd * gg * (ss + 1.0f) + hh; v2u w; w.x = pk2(y.x, y.y); w.y = pk2(y.z, y.w); o8[64 * j] = w; }
    }
}
__device__ __forceinline__ void prep_qk(const Ctx& F, const Args& A, int l) {
    const int gw = F.vcu * NWAVES + F.wave, NGW = F.G * NWAVES;
    const bf16* H = (const bf16*)(F.ws + WS_HID); bf16* QN = (bf16*)(F.ws + WS_QN); bf16* KN = (bf16*)(F.ws + WS_KN);
    const float* qkg = (l == 0) ? A.in[11] : A.in[15];
    const int i = F.lane & 31, hs = F.lane >> 5;
    const float gq0 = qkg[2 * i], gq1 = qkg[2 * i + 1], gk0 = qkg[64 + 2 * i], gk1 = qkg[64 + 2 * i + 1];
    const float inv = exp2f(-(float)(2 * (i & 15)) * (1.0f / 32.0f) * 13.287712379549449f);
    for (int row = gw; row < MTOK; row += NGW) {
        float cs = 1.f, sn = 0.f;
        if (l == 1) { const int t = row & (SEQ - 1); const float pos = (float)((i < 16) ? (t >> 6) : (t & 63)); const float ang = pos * inv; cs = cosf(ang); sn = sinf(ang); }
#pragma unroll
        for (int jj = 0; jj < 5; ++jj) { const int head = 2 * jj + hs;
            const unsigned v = *(const unsigned*)(H + (size_t)row * INCOLS + head * 64 + 2 * i);
            const float x0 = bf_lo(v), x1 = bf_hi(v);
            float ss = x0 * x0 + x1 * x1;
#pragma unroll
            for (int o = 1; o < 32; o <<= 1) ss += __shfl_xor(ss, o);
            const float rstd = rsqrtf(ss * (1.f / 64.f) + EPS);
            const bool isq = head < 8;
            float y0 = x0 * rstd * (isq ? gq0 : gk0), y1 = x1 * rstd * (isq ? gq1 : gk1);
            if (l == 1) { const float r0 = y0 * cs - y1 * sn, r1 = y0 * sn + y1 * cs; y0 = r0; y1 = r1; }
            if (isq) *(unsigned*)(QN + (size_t)row * 512 + head * 64 + 2 * i) = pk2(y0 * att::C2, y1 * att::C2);
            else *(unsigned*)(KN + (size_t)row * 128 + (head - 8) * 64 + 2 * i) = pk2(y0, y1); }
    }
}
__device__ __forceinline__ void prep_conv_l0(const Ctx& F, const Args& A) {
    const int gw = F.vcu * NWAVES + F.wave, NGW = F.G * NWAVES;
    const bf16* H = (const bf16*)(F.ws + WS_HID) + 768; bf16* MIX = (bf16*)(F.ws + WS_XN);
    const float* cw = A.in[13]; const float* cb = A.in[14];
    for (int it = gw; it < 2048; it += NGW) {
        const int row0 = (it >> 3) * 64, c = (it & 7) * 64 + F.lane, t0 = row0 & (SEQ - 1);
        const float w0 = cw[c], w1 = cw[512 + c], w2 = cw[1024 + c], bb = cb[c];
        const bf16* hp = H + (size_t)row0 * INCOLS + c;
        float vp = 0.f; if (t0 > 0) vp = bf1(hp[-(long)INCOLS + 512]) * bf1(hp[-(long)INCOLS + 1024]);
        float vc = bf1(hp[512]) * bf1(hp[1024]);
        for (int r = 0; r < 64; ++r) {
            float vn = 0.f; if (t0 + r + 1 < SEQ) vn = bf1(hp[(size_t)(r + 1) * INCOLS + 512]) * bf1(hp[(size_t)(r + 1) * INCOLS + 1024]);
            const float o = bf1(hp[(size_t)r * INCOLS]) * (w0 * vp + w1 * vc + w2 * vn + bb);
            MIX[(size_t)(row0 + r) * DMODEL + 512 + c] = att::f2bf1(o);
            vp = vc; vc = vn; }
    }
}
__device__ __forceinline__ void prep_conv_l1(const Ctx& F, const Args& A) {
    const int gw = F.vcu * NWAVES + F.wave, NGW = F.G * NWAVES;
    const bf16* H = (const bf16*)(F.ws + WS_HID) + 768; float* ZT = (float*)(F.ws + WS_ZT);
    const float* cw = A.in[16]; const float* cb = A.in[17];
    LAS float* tile = (LAS float*)(F.lds + F.wave * 16640);
    for (int it = gw; it < 2048; it += NGW) {
        const int row0 = (it >> 3) * 64, cg = (it & 7) * 64, c = cg + F.lane, t0 = row0 & (SEQ - 1);
        const int c1 = 512 + c, cv = 1024 + c;
        const float a0 = cw[c1], a1 = cw[1536 + c1], a2 = cw[3072 + c1], ab = cb[c1];
        const float v0 = cw[cv], v1 = cw[1536 + cv], v2 = cw[3072 + cv], vb = cb[cv];
        const bf16* hp = H + (size_t)row0 * INCOLS;
        float xp = 0.f, yp = 0.f; if (t0 > 0) { xp = bf1(hp[-(long)INCOLS + c1]); yp = bf1(hp[-(long)INCOLS + cv]); }
        float xc = bf1(hp[c1]), yc = bf1(hp[cv]);
        for (int r = 0; r < 64; ++r) {
            float xn = 0.f, yn = 0.f; if (t0 + r + 1 < SEQ) { xn = bf1(hp[(size_t)(r + 1) * INCOLS + c1]); yn = bf1(hp[(size_t)(r + 1) * INCOLS + cv]); }
            const float u1 = a0 * xp + a1 * xc + a2 * xn + ab, uv = v0 * yp + v1 * yc + v2 * yn + vb;
            tile[F.lane * 65 + r] = u1 * uv;
            xp = xc; xc = xn; yp = yc; yc = yn; }
        LDS_WAIT(); asm volatile("" ::: "memory");
#pragma unroll 8
        for (int cc = 0; cc < 64; ++cc) ZT[(size_t)(cg + cc) * MTOK + row0 + F.lane] = tile[cc * 65 + F.lane];
        LDS_WAIT(); asm volatile("" ::: "memory");
    }
}
__device__ __forceinline__ void post_l1(const Ctx& F, const Args& A) {
    const int gw = F.vcu * NWAVES + F.wave, NGW = F.G * NWAVES;
    const bf16* H = (const bf16*)(F.ws + WS_HID) + 768; const float* YT = (const float*)(F.ws + WS_ZT); bf16* MIX = (bf16*)(F.ws + WS_XN);
    const float* cw = A.in[16]; const float* cb = A.in[17];
    LAS float* tile = (LAS float*)(F.lds + F.wave * 16640);
    for (int it = gw; it < 2048; it += NGW) {
        const int row0 = (it >> 3) * 64, cg = (it & 7) * 64, c = cg + F.lane, t0 = row0 & (SEQ - 1);
#pragma unroll 8
        for (int cc = 0; cc < 64; ++cc) tile[cc * 65 + F.lane] = YT[(size_t)(cg + cc) * MTOK + row0 + F.lane];
        LDS_WAIT(); asm volatile("" ::: "memory");
        const float a0 = cw[c], a1 = cw[1536 + c], a2 = cw[3072 + c], ab = cb[c];
        const bf16* hp = H + (size_t)row0 * INCOLS + c;
        float xp = 0.f; if (t0 > 0) xp = bf1(hp[-(long)INCOLS]);
        float xc = bf1(hp[0]);
        for (int r = 0; r < 64; ++r) {
            float xn = 0.f; if (t0 + r + 1 < SEQ) xn = bf1(hp[(size_t)(r + 1) * INCOLS]);
            const float u0 = a0 * xp + a1 * xc + a2 * xn + ab;
            MIX[(size_t)(row0 + r) * DMODEL + 512 + c] = att::f2bf1(u0 * tile[F.lane * 65 + r]);
            xp = xc; xc = xn; }
        LDS_WAIT(); asm volatile("" ::: "memory");
    }
}
__device__ __forceinline__ void fft_sincos2pi(float f, float& s, float& c) { s = sinpif(2.0f * f); c = cospif(2.0f * f); }
#define FFT_HD __device__ __forceinline__
#define FFT_OPAQUE(x) asm volatile("" : "+v"(x))
#define FFT_NOUNROLL _Pragma("unroll 1")
#ifndef FFT_HD
#define FFT_HD static inline
#endif
struct cf { float x, y; };
FFT_HD cf cmk(float x, float y) { cf r; r.x = x; r.y = y; return r; }
FFT_HD cf cadd(cf a, cf b) { return cmk(a.x + b.x, a.y + b.y); }
FFT_HD cf csub(cf a, cf b) { return cmk(a.x - b.x, a.y - b.y); }
FFT_HD cf cmul(cf a, cf b) { return cmk(a.x * b.x - a.y * b.y, a.x * b.y + a.y * b.x); }
FFT_HD cf cmulc(cf a, cf b) { return cmk(a.x * b.x + a.y * b.y, a.y * b.x - a.x * b.y); }
#ifndef FFT_OPAQUE
#define FFT_OPAQUE(x)
#define FFT_NOUNROLL
#endif
#define FFT_PAD(i) ((i) + (((i) >> 6) << 2))
constexpr int FFT_N = 16384;
constexpr int FFT_LDS_ELEMS = FFT_N + (FFT_N >> 6) * 4;

template <bool INV> FFT_HD void dft4(cf& a, cf& b, cf& c, cf& d) {
    const cf s0 = cadd(a, c), s1 = csub(a, c), s2 = cadd(b, d), s3 = csub(b, d);
    a = cadd(s0, s2); c = csub(s0, s2);
    if (!INV) { b = cmk(s1.x + s3.y, s1.y - s3.x); d = cmk(s1.x - s3.y, s1.y + s3.x); }
    else      { b = cmk(s1.x - s3.y, s1.y + s3.x); d = cmk(s1.x + s3.y, s1.y - s3.x); }
}
template <bool INV, int M> FFT_HD cf tw16(cf v) {
    constexpr float C1 = 0.92387953251128674f, S1 = 0.38268343236508977f, R = 0.70710678118654752f;
    float c, s;
    if (M == 0) return v;
    if (M == 1) { c = C1; s = S1; } else if (M == 2) { c = R; s = R; } else if (M == 3) { c = S1; s = C1; }
    else if (M == 4) { c = 0.f; s = 1.f; } else if (M == 6) { c = -R; s = R; } else   { c = -C1; s = -S1; }
    const cf w = cmk(c, INV ? s : -s);
    return cmul(v, w);
}
template <bool INV> FFT_HD void dft16(cf (&r)[16]) {
    dft4<INV>(r[0], r[4], r[8], r[12]); dft4<INV>(r[1], r[5], r[9], r[13]); dft4<INV>(r[2], r[6], r[10], r[14]); dft4<INV>(r[3], r[7], r[11], r[15]);
    r[5] = tw16<INV, 1>(r[5]); r[6] = tw16<INV, 2>(r[6]); r[7] = tw16<INV, 3>(r[7]);
    r[9] = tw16<INV, 2>(r[9]); r[10] = tw16<INV, 4>(r[10]); r[11] = tw16<INV, 6>(r[11]);
    r[13] = tw16<INV, 3>(r[13]); r[14] = tw16<INV, 6>(r[14]); r[15] = tw16<INV, 9>(r[15]);
    dft4<INV>(r[0], r[1], r[2], r[3]); dft4<INV>(r[4], r[5], r[6], r[7]); dft4<INV>(r[8], r[9], r[10], r[11]); dft4<INV>(r[12], r[13], r[14], r[15]);
}
#define FFT_XJ(r, j) r[4 * ((j) & 3) + ((j) >> 2)]

template <bool INV, int PS, class Mem> FFT_HD void r16_butterfly(const Mem& mem, int pb, float frac) {
    cf r[16];
#pragma unroll
    for (int k = 0; k < 16; ++k) r[k] = mem.ld(pb + PS * k);
    float s1, c1; fft_sincos2pi(frac, s1, c1);
    const cf w1 = cmk(c1, INV ? s1 : -s1);
    cf w[16];
    w[1] = w1; w[2] = cmul(w1, w1); w[3] = cmul(w[2], w1); w[4] = cmul(w[2], w[2]); w[5] = cmul(w[4], w1); w[6] = cmul(w[4], w[2]); w[7] = cmul(w[4], w[3]);
    w[8] = cmul(w[4], w[4]); w[9] = cmul(w[8], w1); w[10] = cmul(w[8], w[2]); w[11] = cmul(w[8], w[3]); w[12] = cmul(w[8], w[4]); w[13] = cmul(w[8], w[5]); w[14] = cmul(w[8], w[6]); w[15] = cmul(w[8], w[7]);
    if (INV) {
#pragma unroll
        for (int j = 1; j < 16; ++j) r[j] = cmul(r[j], w[j]);
        dft16<true>(r);
#pragma unroll
        for (int k = 0; k < 16; ++k) mem.st(pb + PS * k, FFT_XJ(r, k));
    } else {
        dft16<false>(r);
#pragma unroll
        for (int j = 0; j < 16; ++j) { cf v = FFT_XJ(r, j); if (j) v = cmul(v, w[j]); mem.st(pb + PS * j, v); }
    }
}
template <bool INV, class Mem> FFT_HD void r4_butterfly(const Mem& mem, int id) {
    const int pb = FFT_PAD(4 * id);
    cf a = mem.ld(pb), b = mem.ld(pb + 1), c = mem.ld(pb + 2), d = mem.ld(pb + 3);
    dft4<INV>(a, b, c, d);
    mem.st(pb, a); mem.st(pb + 1, b); mem.st(pb + 2, c); mem.st(pb + 3, d);
}
template <int P, class Mem> FFT_HD void fft_fwd_pass(const Mem& mem, int tid) {
    FFT_OPAQUE(tid);
    if (P == 0) { FFT_NOUNROLL for (int i = 0; i < 2; ++i) { const int id = tid + 512 * i; r16_butterfly<false, 1088>(mem, FFT_PAD(id), (float)id * (1.0f / 16384.0f)); } }
    else if (P == 1) { FFT_NOUNROLL for (int i = 0; i < 2; ++i) { const int id = tid + 512 * i, blk = id >> 6, n = id & 63; r16_butterfly<false, 68>(mem, FFT_PAD(blk * 1024 + n), (float)n * (1.0f / 1024.0f)); } }
    else if (P == 2) { FFT_NOUNROLL for (int i = 0; i < 2; ++i) { const int id = tid + 512 * i, blk = id >> 2, n = id & 3; r16_butterfly<false, 4>(mem, FFT_PAD(blk * 64 + n), (float)n * (1.0f / 64.0f)); } }
    else { FFT_NOUNROLL for (int i = 0; i < 8; ++i) r4_butterfly<false>(mem, tid + 512 * i); }
}
template <int P, class Mem> FFT_HD void fft_inv_pass(const Mem& mem, int tid) {
    FFT_OPAQUE(tid);
    if (P == 0) { FFT_NOUNROLL for (int i = 0; i < 8; ++i) r4_butterfly<true>(mem, tid + 512 * i); }
    else if (P == 1) { FFT_NOUNROLL for (int i = 0; i < 2; ++i) { const int id = tid + 512 * i, blk = id >> 2, n = id & 3; r16_butterfly<true, 4>(mem, FFT_PAD(blk * 64 + n), (float)n * (1.0f / 64.0f)); } }
    else if (P == 2) { FFT_NOUNROLL for (int i = 0; i < 2; ++i) { const int id = tid + 512 * i, blk = id >> 6, n = id & 63; r16_butterfly<true, 68>(mem, FFT_PAD(blk * 1024 + n), (float)n * (1.0f / 1024.0f)); } }
    else { FFT_NOUNROLL for (int i = 0; i < 2; ++i) { const int id = tid + 512 * i; r16_butterfly<true, 1088>(mem, FFT_PAD(id), (float)id * (1.0f / 16384.0f)); } }
}

struct LdsMem { LAS f32x2* p; __device__ __forceinline__ cf ld(int i) const { const f32x2 v = p[i]; return cmk(v.x, v.y); } __device__ __forceinline__ void st(int i, cf v) const { p[i] = (f32x2){v.x, v.y}; } };
#define WG_BAR() do { asm volatile("s_waitcnt vmcnt(0) lgkmcnt(0)" ::: "memory"); __builtin_amdgcn_s_barrier(); asm volatile("" ::: "memory"); } while (0)
__device__ __forceinline__ void fft_forward(const LdsMem& mem, int tid) {
    fft_fwd_pass<0>(mem, tid); WG_BAR(); fft_fwd_pass<1>(mem, tid); WG_BAR(); fft_fwd_pass<2>(mem, tid); WG_BAR(); fft_fwd_pass<3>(mem, tid); WG_BAR();
}
__device__ __forceinline__ void fft_inverse(const LdsMem& mem, int tid) {
    fft_inv_pass<0>(mem, tid); WG_BAR(); fft_inv_pass<1>(mem, tid); WG_BAR(); fft_inv_pass<2>(mem, tid); WG_BAR(); fft_inv_pass<3>(mem, tid); WG_BAR();
}
__device__ __forceinline__ void hyena_filter_item(const Ctx& F, const Args& A, int item) {
    const float* H3 = (const float*)(F.ws + WS_H3); const float* w4 = A.in[24]; cf* KF = (cf*)(F.ws + WS_KF);
    LdsMem mem; mem.p = (LAS f32x2*)F.lds;
    LAS float* wl = (LAS float*)(F.lds + MISC_OFF + 1024);
    LAS float* red = (LAS float*)(F.lds + MISC_OFF + 256);
    const int tid = F.tid; const int cA = item, cB = item + 256;
    if (tid < 256) { const int q = tid >> 6, j = tid & 63; const int col = (q & 1) * 512 + ((q >> 1) ? cB : cA); wl[q * 64 + j] = w4[j * 1024 + col]; }
    WG_BAR();
    const float dA = 15.350567286626973f - (float)cA * (12.280453829301578f / 511.0f), dB = 15.350567286626973f - (float)cB * (12.280453829301578f / 511.0f);
    float ssA = 0.f, ssB = 0.f; float* tmpB = (float*)(KF + (size_t)cB * FFT_N);
#pragma unroll 1
    for (int i = 0; i < 16; ++i) {
        const int l = tid + 512 * i; const f32x4* hr = (const f32x4*)(H3 + (size_t)l * 64);
        float s0 = 0.f, s1 = 0.f, s2 = 0.f, s3 = 0.f;
#pragma unroll
        for (int j4 = 0; j4 < 16; ++j4) { const f32x4 h = hr[j4];
            const f32x4 wa = ((const LAS f32x4*)wl)[j4], wb = ((const LAS f32x4*)wl)[16 + j4], wc = ((const LAS f32x4*)wl)[32 + j4], wd = ((const LAS f32x4*)wl)[48 + j4];
            s0 += h.x * wa.x + h.y * wa.y + h.z * wa.z + h.w * wa.w; s1 += h.x * wb.x + h.y * wb.y + h.z * wb.z + h.w * wb.w;
            s2 += h.x * wc.x + h.y * wc.y + h.z * wc.z + h.w * wc.w; s3 += h.x * wd.x + h.y * wd.y + h.z * wd.z + h.w * wd.w; }
        const float t = (float)l * (1.0f / 8191.0f); const float eA = __expf(-t * dA), eB = __expf(-t * dB);
        const float fA = s0 * eA, bA = (l > 0) ? s1 * eA : 0.f, fB = s2 * eB, bB = (l > 0) ? s3 * eB : 0.f;
        ssA += fA * fA + bA * bA; ssB += fB * fB + bB * bB;
        mem.st(FFT_PAD(l), cmk(fA, 0.f)); mem.st(FFT_PAD(l > 0 ? FFT_N - l : 8192), cmk(bA, 0.f));
        tmpB[l] = fB; tmpB[8192 + l] = bB;
    }
    ssA = wave_sum(ssA); ssB = wave_sum(ssB);
    if (F.lane == 0) { red[F.wave] = ssA; red[8 + F.wave] = ssB; }
    WG_BAR();
    float tA = 0.f, tB = 0.f;
#pragma unroll
    for (int w = 0; w < 8; ++w) { tA += red[w]; tB += red[8 + w]; }
    const float scA = rsqrtf(tA + EPS) * (1.0f / 16384.0f), scB = rsqrtf(tB + EPS) * (1.0f / 16384.0f);
#pragma unroll 1
    for (int ch = 0; ch < 2; ++ch) {
        if (ch == 1) {
#pragma unroll 4
            for (int i = 0; i < 16; ++i) { const int l = tid + 512 * i; const float fB = tmpB[l], bB = tmpB[8192 + l]; mem.st(FFT_PAD(l), cmk(fB, 0.f)); mem.st(FFT_PAD(l > 0 ? FFT_N - l : 8192), cmk(bB, 0.f)); }
            WG_BAR();
        }
        fft_forward(mem, tid);
        const float sc = ch ? scB : scA; cf* dst = KF + (size_t)(ch ? cB : cA) * FFT_N;
#pragma unroll 4
        for (int i = 0; i < 32; ++i) { const int p = tid + 512 * i; const cf v = mem.ld(FFT_PAD(p)); dst[p] = cmk(v.x * sc, v.y * sc); }
        WG_BAR();
    }
}
__device__ __forceinline__ void hyena_conv_item(const Ctx& F, const Args& A, int c) {
    float* ZT = (float*)(F.ws + WS_ZT) + (size_t)c * MTOK; const cf* KF = (const cf*)(F.ws + WS_KF) + (size_t)c * FFT_N; const float skip = A.in[26][c];
    LdsMem mem; mem.p = (LAS f32x2*)F.lds; const int tid = F.tid;
#pragma unroll 4
    for (int i = 0; i < 16; ++i) { const int t = tid + 512 * i; mem.st(FFT_PAD(t), cmk(ZT[t], ZT[SEQ + t])); mem.st(FFT_PAD(SEQ + t), cmk(0.f, 0.f)); }
    WG_BAR();
    fft_forward(mem, tid);
#pragma unroll 4
    for (int i = 0; i < 32; ++i) { const int p = tid + 512 * i; const cf k = KF[p]; mem.st(FFT_PAD(p), cmul(mem.ld(FFT_PAD(p)), k)); }
    WG_BAR();
    fft_inverse(mem, tid);
#pragma unroll 4
    for (int i = 0; i < 16; ++i) { const int t = tid + 512 * i; const cf v = mem.ld(FFT_PAD(t)); const float z0 = ZT[t], z1 = ZT[SEQ + t]; ZT[t] = v.x + skip * z0; ZT[SEQ + t] = v.y + skip * z1; }
    WG_BAR();
}
#ifndef PH_MASK
#define PH_MASK 0xFFFF
#endif
constexpr int NPHASE = 25;
__global__ void __launch_bounds__(NTHR, 2) mk_fwd(Args args) {
    extern __shared__ __attribute__((aligned(16))) unsigned char lds_raw[];
    Ctx F;
    F.lds = (LAS unsigned char*)lds_raw;
    F.tid = threadIdx.x; F.lane = F.tid & 63; F.wave = __builtin_amdgcn_readfirstlane(F.tid >> 6);
    F.G = gridDim.x; { const int bx = blockIdx.x; F.vcu = (F.G % 8 == 0) ? (bx % 8) * (F.G / 8) + bx / 8 : bx; }
    F.out = args.out; F.ws = args.ws;
    volatile LAS unsigned* MISC = (volatile LAS unsigned*)(F.lds + MISC_OFF);
    for (int u = F.tid; u < 64; u += NTHR) MISC[u] = 0u;
    __syncthreads();
    const int lo = args.ph_lo, hi = args.ph_hi;
    const bool multi = (hi - lo) > 1;
    XcdBarrier bar; bar.bar = (unsigned*)(F.ws + WS_CTL) + CW_BAR; bar.x = 0; bar.st = nullptr;
    if (multi) bar = xcd_barrier_post((unsigned*)(F.ws + WS_CTL) + CW_BAR, MISC + 8);
    if (args.use_cg) cooperative_groups::this_grid().sync();
    const Ctx F0 = F;
    for (int p = lo; p < hi; ++p) {
        if (p == 8) continue;
        const __attribute__((address_space(4))) Args* ap = (const __attribute__((address_space(4))) Args*)__builtin_amdgcn_kernarg_segment_ptr(); asm volatile("" : "+s"(ap)); const Args& A = *(const Args*)ap;
        Ctx F = F0; F.tid = threadIdx.x; asm volatile("" : "+v"(F.tid)); asm volatile("" : "+s"(F.vcu)); asm volatile("" : "+s"(F.G)); asm volatile("" : "+s"(F.out)); asm volatile("" : "+s"(F.ws)); F.lane = F.tid & 63; F.wave = __builtin_amdgcn_readfirstlane(F.tid >> 6);
        if (p == 0) { if constexpr ((PH_MASK & 1) != 0) { convert_weights(F, A, 0); mod_gemv(F, A); hyena_h3(F, A); } }
        else {
            const int l = (p - 1) / 12, s = (p - 1) % 12;
            const float* mv = uni_ptr((const float*)(F.ws + WS_MVEC) + (size_t)l * 2 * MODC);
            if (s == 0 || s == 3 || s == 9) { if constexpr ((PH_MASK & 2) != 0) { if (s == 0 && l == 1) convert_weights(F, A, 1); norm_phase(F, A, l, s / 3 > 2 ? 2 : s / 3); } }
            else if (s == 1 || s == 10 || s == 2 || s == 11 || s == 8 || s == 4) { if constexpr ((PH_MASK & 4) != 0) {
                pg8::Gemm g; pg8::EpiAny E; E.kind = 0; E.eb = pg8::EpiBf16{nullptr, 0}; E.es = pg8::EpiSwiglu{nullptr, 0}; E.er = pg8::EpiRes{nullptr, nullptr, 0, nullptr, 0, 0.f};
                if (s == 1 || s == 10) { const int f = s == 10; g = pg8::Gemm{(const bf16*)(F.ws + WS_XN), (const bf16*)(F.ws + WS_W13 + f * W13_STRIDE), MTOK, N13, DMODEL}; E.kind = 1; E.es = pg8::EpiSwiglu{(bf16*)(F.ws + WS_HID), DFFP}; }
                else if (s == 4) { g = pg8::Gemm{(const bf16*)(F.ws + WS_XN), (const bf16*)(F.ws + WS_WIN), MTOK, INCOLS, DMODEL}; E.kind = 0; E.eb = pg8::EpiBf16{(bf16*)(F.ws + WS_HID), INCOLS}; }
                else if (s == 8) { g = pg8::Gemm{(const bf16*)(F.ws + WS_XN), (const bf16*)(F.ws + WS_WOUT), MTOK, DMODEL, DMODEL}; E.kind = 2; E.er = pg8::EpiRes{F.out, F.out, DMODEL, mv + 1 * 3072 + 2048, MODC, 1.0f}; }
                else { const int f = s == 11; g = pg8::Gemm{(const bf16*)(F.ws + WS_HID), (const bf16*)(F.ws + WS_W2T + f * W2T_STRIDE), MTOK, DMODEL, DFFP}; E.kind = 2;
                    E.er = pg8::EpiRes{(l == 0 && f == 0) ? A.in[0] : F.out, F.out, DMODEL, mv + (f ? 2 : 0) * 3072 + 2048, MODC, 0.5f}; }
                g.A = uni_ptr(g.A); g.Bt = uni_ptr(g.Bt); g.N = uni_i(g.N); g.K = uni_i(g.K); E.kind = uni_i(E.kind);
                E.eb.O = uni_ptr(E.eb.O); E.eb.ldc = uni_i(E.eb.ldc); E.es.O = uni_ptr(E.es.O); E.es.ldc = uni_i(E.es.ldc);
                E.er.base = uni_ptr(E.er.base); E.er.out = uni_ptr(E.er.out); E.er.gate = uni_ptr(E.er.gate); E.er.ldc = uni_i(E.er.ldc); E.er.gstride = uni_i(E.er.gstride);
                pg8::StaticOrder S; S.init(MTOK, g.N, F.G, (int)blockIdx.x);
                pg8::gemm_phase<pg8::EpiAny, pg8::StaticOrder, true, true>(F.lds, g, S, E); } }
            else if (s == 5) { if constexpr ((PH_MASK & 32) != 0) { prep_qk(F, A, l); if (l == 0) prep_conv_l0(F, A); else prep_conv_l1(F, A); } }
            else if (s == 6) { if constexpr ((PH_MASK & 64) != 0) {
                const bf16* QN = (const bf16*)(F.ws + WS_QN); const bf16* KN = (const bf16*)(F.ws + WS_KN); const bf16* V = (const bf16*)(F.ws + WS_HID) + 640; bf16* MIX = (bf16*)(F.ws + WS_XN);
                if constexpr ((PH_MASK & 256) != 0)
#pragma unroll 1
                for (int i = 0; i < 2; ++i) { const int u = F.vcu * 2 + i, bh = u >> 5, qb = u & 31, b = bh >> 3, h = bh & 7;
                    att::attn_unit(l == 0, b, h, qb, QN, KN, V, MIX, (att::lds_ptr)F.lds, A.in[2], l == 0 ? A.in[12][h] * att::LOG2E : 0.f); }
                if constexpr ((PH_MASK & 512) != 0) if (l == 0) { hyena_filter_item(F, A, F.vcu); }
                if constexpr ((PH_MASK & 1024) != 0) if (l == 1) {
#pragma unroll 1
                    for (int k = 0; k < 2; ++k) hyena_conv_item(F, A, F.vcu + 256 * k); } } }
            else if (s == 7) { if constexpr ((PH_MASK & 128) != 0) { post_l1(F, A); } }
        }
        if (p + 1 < hi) { XcdBarrier b2 = bar; asm volatile("" : "+s"(b2.bar)); asm volatile("" : "+s"(b2.x)); xcd_barrier(b2); }
    }
}

extern "C" void kernel_launch(void* const* d_in, const int* in_sizes, int n_in, void* d_out, int out_size, void* d_ws, size_t ws_size, hipStream_t stream) {
    static int grid = 0;
    if (grid == 0) {
        if (n_in != 27 || out_size != MTOK * DMODEL || ws_size < WS_END) { fprintf(stderr, "kernel_launch: unexpected problem (n_in %d, out %d, ws %zu)\n", n_in, out_size, ws_size); grid = -1; return; }
        int dev = 0, cus = 0, per_cu = 0;
        if (hipGetDevice(&dev) != hipSuccess || hipDeviceGetAttribute(&cus, hipDeviceAttributeMultiprocessorCount, dev) != hipSuccess) { grid = -1; return; }
        if (hipFuncSetAttribute((const void*)mk_fwd, hipFuncAttributeMaxDynamicSharedMemorySize, LDS_BYTES) != hipSuccess) { fprintf(stderr, "kernel_launch: hipFuncSetAttribute failed\n"); grid = -1; return; }
        if (hipOccupancyMaxActiveBlocksPerMultiprocessor(&per_cu, (const void*)mk_fwd, NTHR, LDS_BYTES) != hipSuccess || per_cu < 1) { fprintf(stderr, "kernel_launch: occupancy query says %d blocks per CU\n", per_cu); per_cu = 1; }
        (void)hipGetLastError();
        grid = cus;
        if (grid != 256) fprintf(stderr, "kernel_launch: %d CUs (tuned for 256)\n", grid);
    }
    if (grid < 0) return;
    (void)hipMemsetAsync((char*)d_ws + WS_CTL, 0, CTL_ZERO_BYTES, stream);
    Args a{};
    for (int i = 0; i < 27; ++i) a.in[i] = (const float*)d_in[i];
    a.out = (float*)d_out; a.ws = (unsigned char*)d_ws; a.use_cg = 0; a.pad = 0;
#if MK_SINGLE
    a.ph_lo = 0; a.ph_hi = NPHASE;
    void* kargs[] = {&a};
    hipError_t e = hipLaunchCooperativeKernel((const void*)mk_fwd, dim3(grid), dim3(NTHR), kargs, LDS_BYTES, stream);
    if (e != hipSuccess) fprintf(stderr, "cooperative launch failed: %s (grid %d)\n", hipGetErrorString(e), grid);
#else
    for (int p = 0; p < NPHASE; ++p) { if (p == 8) continue; a.ph_lo = p; a.ph_hi = p + 1; hipLaunchKernelGGL(mk_fwd, dim3(grid), dim3(NTHR), LDS_BYTES, stream, a); }
#endif
}
```

```cpp
#include <hip/hip_runtime.h>
#include <hip/hip_cooperative_groups.h>
#include <cstdio>
#include <cstdint>
#include <cmath>
#define MK_SINGLE 1
namespace pg8 {
#define PG8_LAS __attribute__((address_space(3)))
typedef unsigned short bf16_t;
typedef short bf16x8 __attribute__((ext_vector_type(8)));
typedef float f32x4 __attribute__((ext_vector_type(4)));
typedef unsigned u32x4 __attribute__((ext_vector_type(4)));
constexpr int BM = 256, BK = 64, HALF = 128, HTB = HALF * BK * 2  , STAGE_BYTES = 8 * HTB, NXCD = 8, WGM = 8;

__host__ __device__ __forceinline__ int lds_byte(int r, int c) { const int st = (r >> 4) * 2 + (c >> 5), rr = r & 15, cc = c & 31, ob = rr * 64 + cc * 2; return st * 1024 + (ob ^ (((ob >> 9) & 1) << 5)); }
__host__ __device__ __forceinline__ void stage_rc(int b, int& R, int& C) { const int st = b / 1024, sb = b % 1024, swz = sb ^ (((sb >> 9) & 1) << 5); R = (st >> 1) * 16 + swz / 64; C = (st & 1) * 32 + (swz % 64) / 2; }
__host__ __device__ __forceinline__ int perm32(int rho) { const int n = rho >> 4, i = rho & 15; return 8 * (i >> 2) + 4 * n + (i & 3); }

struct Unit { int pm, pn; };
struct Gemm { const bf16_t* A; const bf16_t* Bt; int M, N, K; };

struct StaticOrder {
    int nM, nN, nwg, G, c;
    __host__ __device__ void init(int M, int N, int G_, int c_) { nM = M / BM; nN = N / BM; nwg = nM * nN; G = G_; c = c_; }
    __host__ __device__ bool next(int i, Unit& u) const {
        const long L = (long)i * G + c; if (L >= nwg) return false;
        int wgid = (int)L; { const int q = nwg / NXCD, r = nwg % NXCD, xcd = wgid % NXCD, off = wgid / NXCD; wgid = (xcd < r ? xcd * (q + 1) : r * (q + 1) + (xcd - r) * q) + off; }
        const int nig = WGM * nN, gid = wgid / nig, fm = gid * WGM, gsz = (nM - fm) < WGM ? (nM - fm) : WGM;
        u.pm = fm + ((wgid % nig) % gsz); u.pn = (wgid % nig) / gsz; return true;
    }
    __device__ __forceinline__ void a_ready(const Unit&) const {}
    __device__ __forceinline__ void done(const Unit&) const {}
};

__device__ __forceinline__ unsigned cvt_pk_bf16(float lo, float hi) { unsigned r; asm volatile("v_cvt_pk_bf16_f32 %0, %1, %2" : "=v"(r) : "v"(lo), "v"(hi)); return r; }
typedef float f32x2 __attribute__((ext_vector_type(2)));
typedef float f32x2 __attribute__((ext_vector_type(2)));
__device__ __forceinline__ float silu_mul(float g, float u) { const float e = __builtin_amdgcn_exp2f(g * (-1.4426950408889634f)); return g * __builtin_amdgcn_rcpf(1.0f + e) * u; }
struct EpiBf16 {
    static constexpr bool PERM = true, AFTER_DRAIN = false;
    bf16_t* O; int ldc;
    __device__ __forceinline__ void operator()(const f32x4 (&acc)[2][2][4][2], const Unit& u, int wr, int wc, int fr, int fq) const {
        const int row0 = u.pm * BM + wr * 64 + fr; const int col0 = u.pn * BM + wc * 32 + 8 * fq;
#pragma unroll
        for (int ai = 0; ai < 2; ++ai)
#pragma unroll
            for (int m = 0; m < 4; ++m) { bf16_t* rowp = O + (size_t)(row0 + ai * HALF + m * 16) * ldc + col0;
#pragma unroll
                for (int bj = 0; bj < 2; ++bj) { const f32x4 v0 = acc[ai][bj][m][0], v1 = acc[ai][bj][m][1];
                    u32x4 w; w.x = cvt_pk_bf16(v0[0], v0[1]); w.y = cvt_pk_bf16(v0[2], v0[3]); w.z = cvt_pk_bf16(v1[0], v1[1]); w.w = cvt_pk_bf16(v1[2], v1[3]);
                    *(u32x4*)(rowp + bj * HALF) = w; } }
    }
};
struct EpiSwiglu {
    static constexpr bool PERM = true, AFTER_DRAIN = false;
    bf16_t* O; int ldc;
    __device__ __forceinline__ void operator()(const f32x4 (&acc)[2][2][4][2], const Unit& u, int wr, int wc, int fr, int fq) const {
        const int row0 = u.pm * BM + wr * 64 + fr; const int col0 = u.pn * HALF + wc * 32 + 8 * fq;
#pragma unroll
        for (int ai = 0; ai < 2; ++ai)
#pragma unroll
            for (int m = 0; m < 4; ++m) { bf16_t* rowp = O + (size_t)(row0 + ai * HALF + m * 16) * ldc + col0;
                const f32x4 g0 = acc[ai][0][m][0], g1 = acc[ai][0][m][1], u0 = acc[ai][1][m][0], u1 = acc[ai][1][m][1];
                u32x4 w; w.x = cvt_pk_bf16(silu_mul(g0[0], u0[0]), silu_mul(g0[1], u0[1])); w.y = cvt_pk_bf16(silu_mul(g0[2], u0[2]), silu_mul(g0[3], u0[3]));
                w.z = cvt_pk_bf16(silu_mul(g1[0], u1[0]), silu_mul(g1[1], u1[1])); w.w = cvt_pk_bf16(silu_mul(g1[2], u1[2]), silu_mul(g1[3], u1[3]));
                *(u32x4*)rowp = w; }
    }
};
struct EpiRes {
    static constexpr bool PERM = true, AFTER_DRAIN = false;
    const float* base; float* out; int ldc; const float* gate; int gstride; float gsc;
    __device__ __forceinline__ void operator()(const f32x4 (&acc)[2][2][4][2], const Unit& u, int wr, int wc, int fr, int fq) const {
        const int row0 = u.pm * BM + wr * 64 + fr; const int col0 = u.pn * BM + wc * 32 + 8 * fq;
        const float* gp = gate + (size_t)(u.pm >> 5) * gstride + col0;
        f32x4 gv[2][2];
#pragma unroll
        for (int bj = 0; bj < 2; ++bj)
#pragma unroll
            for (int n = 0; n < 2; ++n) gv[bj][n] = *(const f32x4*)(gp + bj * HALF + n * 4) * gsc;
#pragma unroll
        for (int ai = 0; ai < 2; ++ai)
#pragma unroll
            for (int m = 0; m < 4; ++m) { const size_t off = (size_t)(row0 + ai * HALF + m * 16) * ldc + col0;
#pragma unroll
                for (int bj = 0; bj < 2; ++bj)
#pragma unroll
                    for (int n = 0; n < 2; ++n) { const f32x4 bs = *(const f32x4*)(base + off + bj * HALF + n * 4); *(f32x4*)(out + off + bj * HALF + n * 4) = bs + gv[bj][n] * acc[ai][bj][m][n]; } }
    }
};
struct EpiAny {
    static constexpr bool PERM = true, AFTER_DRAIN = false;
    int kind; EpiBf16 eb; EpiSwiglu es; EpiRes er;
    __device__ __forceinline__ void operator()(const f32x4 (&acc)[2][2][4][2], const Unit& u, int wr, int wc, int fr, int fq) const {
        if (kind == 0) eb(acc, u, wr, wc, fr, fq); else if (kind == 1) es(acc, u, wr, wc, fr, fq); else er(acc, u, wr, wc, fr, fq);
    }
};

template <class Epi, class Sched, bool ALIGN_EPI = false, bool SP2 = false>
__device__ __forceinline__ void gemm_phase(PG8_LAS unsigned char* lds, const Gemm g, const Sched& S, const Epi& E) {
    int tid_ = threadIdx.x; asm volatile("" : "+v"(tid_));
    const int tid = tid_, wid = __builtin_amdgcn_readfirstlane(tid >> 6), lane = tid & 63, wr = wid >> 2, wc = wid & 3, fr = lane & 15, fq = lane >> 4;
    const int K = g.K, nt = K / BK;
    unsigned voffA[2], voffB[2];
#pragma unroll
    for (int i = 0; i < 2; ++i) { int R, C; stage_rc(tid * 16 + i * 8192, R, C); const int Rb = Epi::PERM ? ((R & ~31) + perm32(R & 31)) : R;
        voffA[i] = (unsigned)(R * K + C) * 2u; voffB[i] = (unsigned)(Rb * K + C) * 2u; }
    const size_t kstep = (size_t)(BK * 2);
    const size_t hstep = (size_t)HALF * K * 2;
    const size_t tstep = 2 * hstep;
    const unsigned ldsw = (unsigned)wid * 1024u;
    const int aoff = lds_byte(wr * 64 + fr, fq * 8), boff = lds_byte(wc * 32 + fr, fq * 8);
#define PG8_SA(b, h) (((b) * 2 + (h)) * HTB)
#define PG8_SB(b, h) ((4 + (b) * 2 + (h)) * HTB)
#define PG8_STAGE(bufoff, gbase, voff) do { _Pragma("unroll") for (int _i = 0; _i < 2; ++_i) \
        __builtin_amdgcn_global_load_lds((const unsigned*)((const char*)(gbase) + (voff)[_i]), (PG8_LAS unsigned*)(lds + (bufoff) + ldsw + _i * 8192), 16, 0, 0); } while (0)
#define PG8_LDA(dst, b, h) do { _Pragma("unroll") for (int m = 0; m < 4; ++m) _Pragma("unroll") for (int k = 0; k < 2; ++k) dst[m][k] = *(const PG8_LAS bf16x8*)(lds + PG8_SA(b, h) + aoff + m * 2048 + k * 1024); } while (0)
#define PG8_LDB(dst, b, h) do { _Pragma("unroll") for (int n = 0; n < 2; ++n) _Pragma("unroll") for (int k = 0; k < 2; ++k) dst[n][k] = *(const PG8_LAS bf16x8*)(lds + PG8_SB(b, h) + boff + n * 2048 + k * 1024); } while (0)
#define PG8_MMA(ai, bj, At, Bt) do { __builtin_amdgcn_s_setprio(1); _Pragma("unroll") for (int m = 0; m < 4; ++m) _Pragma("unroll") for (int n = 0; n < 2; ++n) _Pragma("unroll") for (int k = 0; k < 2; ++k) \
        acc[ai][bj][m][n] = __builtin_amdgcn_mfma_f32_16x16x32_bf16(Bt[n][k], At[m][k], acc[ai][bj][m][n], 0, 0, 0); __builtin_amdgcn_s_setprio(0); } while (0)
#define PG8_WAIT_V(n) asm volatile("s_waitcnt vmcnt(" #n ")" ::: "memory")
#define PG8_WAIT_L(n) asm volatile("s_waitcnt lgkmcnt(" #n ")" ::: "memory")
#define PG8_BAR __builtin_amdgcn_s_barrier()
#define PG8_SCHED __builtin_amdgcn_sched_barrier(0)
    Unit cur, nxt; int ui = 0;
    if (!S.next(0, cur)) return;
    f32x4 acc[2][2][4][2];
#pragma unroll
    for (int a = 0; a < 2; ++a)
#pragma unroll
        for (int b = 0; b < 2; ++b)
#pragma unroll
            for (int m = 0; m < 4; ++m)
#pragma unroll
                for (int n = 0; n < 2; ++n) acc[a][b][m][n] = (f32x4){0.f, 0.f, 0.f, 0.f};
    bf16x8 At[4][2], B0[2][2], B1[2][2];
    const char* cA = (const char*)g.A + (size_t)cur.pm * tstep; const char* cB = (const char*)g.Bt + (size_t)cur.pn * tstep;
    S.a_ready(cur);
    if constexpr (SP2) {
        PG8_STAGE(PG8_SB(0, 0), cB, voffB); PG8_STAGE(PG8_SB(0, 1), cB + hstep, voffB); PG8_STAGE(PG8_SA(0, 0), cA, voffA); PG8_STAGE(PG8_SA(0, 1), cA + hstep, voffA);
        if (wr == 1) PG8_BAR;
        PG8_WAIT_V(2); PG8_BAR;
        PG8_STAGE(PG8_SB(1, 0), cB + kstep, voffB); PG8_STAGE(PG8_SA(1, 0), cA + kstep, voffA); PG8_STAGE(PG8_SB(1, 1), cB + hstep + kstep, voffB);
        PG8_WAIT_V(6); PG8_BAR;
    } else {
        PG8_STAGE(PG8_SB(0, 0), cB, voffB); PG8_STAGE(PG8_SA(0, 0), cA, voffA); PG8_STAGE(PG8_SB(0, 1), cB + hstep, voffB); PG8_STAGE(PG8_SA(0, 1), cA + hstep, voffA);
        if (wr == 1) PG8_BAR;
        PG8_WAIT_V(4); PG8_BAR;
        PG8_STAGE(PG8_SB(1, 0), cB + kstep, voffB); PG8_STAGE(PG8_SA(1, 0), cA + kstep, voffA); PG8_STAGE(PG8_SB(1, 1), cB + hstep + kstep, voffB);
        PG8_WAIT_V(6); PG8_BAR;
    }
    for (;;) {
        const bool has_next = S.next(ui + 1, nxt);
        const char* nA = has_next ? (const char*)g.A + (size_t)nxt.pm * tstep : cA; const char* nB = has_next ? (const char*)g.Bt + (size_t)nxt.pn * tstep : cB;
        for (int t = 0; t < nt; t += 2) {
            const bool last = (t == nt - 2);
            const char* a1 = cA + (size_t)(t + 1) * kstep;
            const char* a2 = last ? nA : cA + (size_t)(t + 2) * kstep; const char* b2 = last ? nB : cB + (size_t)(t + 2) * kstep;
            const char* a3 = a2 + kstep; const char* b3 = b2 + kstep;
            if (last && has_next) S.a_ready(nxt);
            if constexpr (SP2) {
            PG8_LDB(B0, 0, 0); PG8_LDB(B1, 0, 1); PG8_SCHED; PG8_LDA(At, 0, 0); PG8_STAGE(PG8_SA(1, 1), a1 + hstep, voffA);
            PG8_WAIT_V(8); PG8_WAIT_L(0); PG8_BAR; PG8_MMA(0, 0, At, B0); PG8_MMA(0, 1, At, B1); PG8_BAR; PG8_SCHED;
            PG8_LDA(At, 0, 1); PG8_STAGE(PG8_SB(0, 0), b2, voffB); PG8_STAGE(PG8_SB(0, 1), b2 + hstep, voffB); PG8_STAGE(PG8_SA(0, 0), a2, voffA);
            PG8_WAIT_V(8); PG8_WAIT_L(0); PG8_BAR; PG8_MMA(1, 0, At, B0); PG8_MMA(1, 1, At, B1); PG8_BAR; PG8_SCHED;
            PG8_LDB(B0, 1, 0); PG8_LDB(B1, 1, 1); PG8_SCHED; PG8_LDA(At, 1, 0); PG8_STAGE(PG8_SA(0, 1), a2 + hstep, voffA);
            PG8_WAIT_V(8); PG8_WAIT_L(0); PG8_BAR; PG8_MMA(0, 0, At, B0); PG8_MMA(0, 1, At, B1); PG8_BAR; PG8_SCHED;
            PG8_LDA(At, 1, 1); PG8_STAGE(PG8_SB(1, 0), b3, voffB); PG8_STAGE(PG8_SB(1, 1), b3 + hstep, voffB); PG8_STAGE(PG8_SA(1, 0), a3, voffA);
            PG8_WAIT_V(8); PG8_WAIT_L(0); PG8_BAR; PG8_MMA(1, 0, At, B0); PG8_MMA(1, 1, At, B1); PG8_BAR; PG8_SCHED;
            } else {
            PG8_LDB(B0, 0, 0); PG8_SCHED; PG8_LDA(At, 0, 0); PG8_STAGE(PG8_SA(1, 1), a1 + hstep, voffA);
            PG8_WAIT_L(8); PG8_BAR; PG8_WAIT_L(0); PG8_MMA(0, 0, At, B0); PG8_BAR; PG8_SCHED;
            PG8_LDB(B1, 0, 1); PG8_STAGE(PG8_SB(0, 0), b2, voffB);
            PG8_BAR; PG8_WAIT_L(0); PG8_MMA(0, 1, At, B1); PG8_BAR;
            PG8_LDA(At, 0, 1); PG8_STAGE(PG8_SA(0, 0), a2, voffA);
            PG8_BAR; PG8_WAIT_L(0); PG8_MMA(1, 0, At, B0); PG8_BAR; PG8_SCHED;
            PG8_STAGE(PG8_SB(0, 1), b2 + hstep, voffB);
            PG8_WAIT_V(6); PG8_BAR; PG8_MMA(1, 1, At, B1); PG8_BAR;
            PG8_LDB(B0, 1, 0); PG8_SCHED; PG8_LDA(At, 1, 0); PG8_STAGE(PG8_SA(0, 1), a2 + hstep, voffA);
            PG8_WAIT_L(8); PG8_BAR; PG8_WAIT_L(0); PG8_MMA(0, 0, At, B0); PG8_BAR; PG8_SCHED;
            PG8_LDB(B1, 1, 1); PG8_STAGE(PG8_SB(1, 0), b3, voffB);
            PG8_BAR; PG8_WAIT_L(0); PG8_MMA(0, 1, At, B1); PG8_BAR;
            PG8_LDA(At, 1, 1); PG8_STAGE(PG8_SA(1, 0), a3, voffA);
            PG8_BAR; PG8_WAIT_L(0); PG8_MMA(1, 0, At, B0); PG8_BAR; PG8_SCHED;
            PG8_STAGE(PG8_SB(1, 1), b3 + hstep, voffB);
            PG8_WAIT_V(6); PG8_BAR; PG8_MMA(1, 1, At, B1); PG8_BAR;
            }
        }
        if constexpr (ALIGN_EPI) { if (wr == 0) PG8_BAR; }
        if constexpr (!Epi::AFTER_DRAIN) { E(acc, cur, wr, wc, fr, fq); S.done(cur); }
        if (!has_next) break;
#pragma unroll
        for (int a = 0; a < 2; ++a)
#pragma unroll
            for (int b = 0; b < 2; ++b)
#pragma unroll
                for (int m = 0; m < 4; ++m)
#pragma unroll
                    for (int n = 0; n < 2; ++n) acc[a][b][m][n] = (f32x4){0.f, 0.f, 0.f, 0.f};
        cur = nxt; cA = nA; cB = nB; ++ui;
        if constexpr (ALIGN_EPI) { if (wr == 1) PG8_BAR; }
    }
    PG8_WAIT_V(0);
    if constexpr (!ALIGN_EPI) { if (wr == 0) PG8_BAR; }
    PG8_BAR;
    if constexpr (Epi::AFTER_DRAIN) { E.fused(acc, cur, wr, wc, fr, fq, lds, wid, lane); S.done(cur); }
#undef PG8_SA
#undef PG8_SB
#undef PG8_STAGE
#undef PG8_LDA
#undef PG8_LDB
#undef PG8_MMA
#undef PG8_WAIT_V
#undef PG8_WAIT_L
#undef PG8_BAR
#undef PG8_SCHED
}
}
namespace att {
using bf16_t = unsigned short;
using bf16x8 = __attribute__((ext_vector_type(8))) short;
using s16x4 = __attribute__((ext_vector_type(4))) short;
using f32x16 = __attribute__((ext_vector_type(16))) float;
using u32x4 = __attribute__((ext_vector_type(4))) unsigned;
typedef __attribute__((address_space(3))) const char* lds_cptr;
typedef __attribute__((address_space(3))) char* lds_ptr;
typedef __attribute__((address_space(3))) float LDSF;
typedef __attribute__((address_space(3))) unsigned short LDSH;
constexpr int SEQ = 8192, QP = 512, KP = 128, VP = 2304, OP = 1024;
constexpr int SLOTB = 8192;
constexpr int L_K = 0, L_V = 2 * SLOTB, L_WS = 4 * SLOTB, L_OST = L_WS + 8 * 64 * 4, L_LUT = L_OST + 8 * 4096, L_END = L_LUT + 768 * 4;
constexpr float LOG2E = 1.4426950408889634f;
constexpr float C2 = 0.125f * LOG2E;
__device__ __forceinline__ int crow(int r, int hi) { return (r & 3) + 8 * (r >> 2) + 4 * hi; }
__device__ __forceinline__ void glds16(const void* gsrc, unsigned lds_dst) { unsigned keep;
  asm volatile("s_mov_b32 %0, m0\n\ts_mov_b32 m0, %2\n\ts_nop 0\n\tglobal_load_lds_dwordx4 %1, off\n\ts_mov_b32 m0, %0" : "=&s"(keep) : "v"(gsrc), "s"(lds_dst) : "memory"); }
typedef float f32x2_t __attribute__((ext_vector_type(2))); typedef __bf16 bf16x2_t __attribute__((ext_vector_type(2)));
__device__ __forceinline__ unsigned cvtpk_s(float lo, float hi) { f32x2_t v = {lo, hi}; bf16x2_t b = __builtin_convertvector(v, bf16x2_t); return __builtin_bit_cast(unsigned, b); }
__device__ __forceinline__ unsigned short f2bf1(float f) { return (unsigned short)(cvtpk_s(f, 0.f) & 0xffffu); }
#define ATT_WAIT_BAR(N) asm volatile("s_waitcnt vmcnt(" #N ") lgkmcnt(0)\n\ts_barrier" ::: "memory")
#define ATT_SBAR() __builtin_amdgcn_sched_barrier(0)
__device__ __forceinline__ void qkt(f32x16& p0, f32x16& p1, lds_cptr kb, const bf16x8* qr) {
  const f32x16 z = {};
#pragma unroll
  for (int d0 = 0; d0 < 4; ++d0) {
    const bf16x8 b0 = *(const __attribute__((address_space(3))) bf16x8*)(kb + d0 * 2048);
    const bf16x8 b1 = *(const __attribute__((address_space(3))) bf16x8*)(kb + d0 * 2048 + 512);
    if (d0 == 0) { p0 = __builtin_amdgcn_mfma_f32_32x32x16_bf16(b0, qr[0], z, 0, 0, 0); p1 = __builtin_amdgcn_mfma_f32_32x32x16_bf16(b1, qr[0], z, 0, 0, 0); }
    else { p0 = __builtin_amdgcn_mfma_f32_32x32x16_bf16(b0, qr[d0], p0, 0, 0, 0); p1 = __builtin_amdgcn_mfma_f32_32x32x16_bf16(b1, qr[d0], p1, 0, 0, 0); } }
}
__device__ __forceinline__ void pv(f32x16* o, int vb, bf16x8 pa0, bf16x8 pa1, bf16x8 pa2, bf16x8 pa3) {
#pragma unroll
  for (int d0 = 0; d0 < 2; ++d0) { s16x4 lo[4], hi[4];
#pragma unroll
    for (int ks = 0; ks < 4; ++ks) {
      asm volatile("ds_read_b64_tr_b16 %0,%1 offset:%c2" : "=&v"(lo[ks]) : "v"(vb), "i"(d0 * 4096 + ks * 1024) : "memory");
      asm volatile("ds_read_b64_tr_b16 %0,%1 offset:%c2" : "=&v"(hi[ks]) : "v"(vb), "i"(d0 * 4096 + ks * 1024 + 512) : "memory"); }
    asm volatile("s_waitcnt lgkmcnt(0)" ::: "memory"); ATT_SBAR();
#define ATT_PK(k) (bf16x8){lo[k][0], lo[k][1], lo[k][2], lo[k][3], hi[k][0], hi[k][1], hi[k][2], hi[k][3]}
    o[d0] = __builtin_amdgcn_mfma_f32_32x32x16_bf16(pa0, ATT_PK(0), o[d0], 0, 0, 0);
    o[d0] = __builtin_amdgcn_mfma_f32_32x32x16_bf16(pa1, ATT_PK(1), o[d0], 0, 0, 0);
    o[d0] = __builtin_amdgcn_mfma_f32_32x32x16_bf16(pa2, ATT_PK(2), o[d0], 0, 0, 0);
    o[d0] = __builtin_amdgcn_mfma_f32_32x32x16_bf16(pa3, ATT_PK(3), o[d0], 0, 0, 0);
#undef ATT_PK
  }
}
__device__ __forceinline__ int t5_bucket(int rel) {
  const int n = rel < 0 ? -rel : rel;
  const int large = n < 12 ? 8 : n < 16 ? 9 : n < 23 ? 10 : n < 32 ? 11 : n < 46 ? 12 : n < 64 ? 13 : n < 91 ? 14 : 15;
  return (rel > 0 ? 16 : 0) + (n < 8 ? n : large);
}
__device__ __forceinline__ void attn_unit(const bool WIN, int b, int h, int qb, const bf16_t* Q, const bf16_t* __restrict__ K, const bf16_t* __restrict__ V, bf16_t* O, lds_ptr shm,
                                                               const float* rel_table, float sink2) {
  int tid_ = threadIdx.x; asm volatile("" : "+v"(tid_));
  const int tid = tid_, lane = tid & 63, r32 = lane & 31, hi = lane >> 5; const int wid = __builtin_amdgcn_readfirstlane(tid >> 6);
  const long rowbase = (long)b * SEQ; const int q0 = qb * 256; const int kvh = h >> 2;
  const unsigned lds0 = (unsigned)(uintptr_t)shm;
  LDSF* wsf = (LDSF*)(shm + L_WS) + wid * 64;
  LDSF* lut = (LDSF*)(shm + L_LUT);
  const bf16_t* Kh = K + rowbase * KP + kvh * 64; const bf16_t* Vh = V + rowbase * VP + kvh * 64;
  const bf16_t* ksrc = Kh + (long)lane * KP + wid * 8;
  const bf16_t* vsrc = Vh + (long)(16 * (wid & 3) + (lane >> 2)) * VP + (wid >> 2) * 32 + (lane & 3) * 8;
  const unsigned kdst = lds0 + L_K + wid * 1024, vdst = lds0 + L_V + wid * 1024;
#define ATT_DMA_K(t, slot) glds16(ksrc + (long)(t) * 64 * KP, (unsigned)__builtin_amdgcn_readfirstlane(kdst + (slot)))
#define ATT_DMA_V(t, slot) glds16(vsrc + (long)(t) * 64 * VP, (unsigned)__builtin_amdgcn_readfirstlane(vdst + (slot)))
  const int vb0 = (int)(lds0 + L_V) + ((lane >> 4) & 1) * 32 + (lane & 3) * 8 + (4 * hi + ((lane & 15) >> 2)) * 64;
  const lds_cptr shm3 = (lds_cptr)shm; const lds_cptr kp0 = shm3 + L_K + hi * 1024 + r32 * 16;
  int t_lo = 0, t_hi = SEQ / 64;
  if (WIN) { t_lo = q0 / 64 - 2; if (t_lo < 0) t_lo = 0; t_hi = q0 / 64 + 6; if (t_hi > SEQ / 64) t_hi = SEQ / 64; }
  ATT_DMA_K(t_lo, 0); ATT_DMA_V(t_lo, 0);
  if (WIN) { for (int i = tid; i < 768; i += 512) { const int rel = i - 384; const int n = rel < 0 ? -rel : rel; float v = -INFINITY; if (n <= 128) v = rel_table[t5_bucket(rel) * 8 + h] * LOG2E; lut[i] = v; } }
  const bf16_t* Qw = Q + (rowbase + q0 + wid * 32) * QP + h * 64;
  bf16x8 qr[4];
#pragma unroll
  for (int d0 = 0; d0 < 4; ++d0) qr[d0] = *reinterpret_cast<const bf16x8*>(&Qw[(long)r32 * QP + d0 * 16 + hi * 8]);
  float mhat = WIN ? sink2 : -1.0e30f, l_reg = (WIN && hi == 0) ? 1.f : 0.f; f32x16 o[2]; o[0] = f32x16{}; o[1] = f32x16{};
  const int qw = q0 + wid * 32;
  for (int t = t_lo; t < t_hi; ++t) {
    const int slot = ((t - t_lo) & 1) * SLOTB;
    if (t + 1 < t_hi) { ATT_DMA_K(t + 1, slot ^ SLOTB); ATT_DMA_V(t + 1, slot ^ SLOTB); ATT_WAIT_BAR(2); } else { ATT_WAIT_BAR(0); }
    const int tb = t * 64;
    const bool act = !WIN || !(tb > qw + 31 + 128 || tb + 63 < qw - 128);
    if (act) {
      f32x16 p0, p1; qkt(p0, p1, kp0 + slot, qr);
      if (WIN) { const int base = tb - (qw + r32) + 384 + 4 * hi;
#pragma unroll
        for (int r = 0; r < 16; ++r) { const int ix = base + (r & 3) + 8 * (r >> 2); p0[r] += lut[ix]; p1[r] += lut[ix + 32]; } }
      float m = p0[0];
#pragma unroll
      for (int r = 0; r < 16; ++r) { m = __builtin_fmaxf(m, p0[r]); m = __builtin_fmaxf(m, p1[r]); }
      { auto rr = __builtin_amdgcn_permlane32_swap(__float_as_uint(m), __float_as_uint(m), false, false); m = __builtin_fmaxf(__uint_as_float(rr[0]), __uint_as_float(rr[1])); }
      const float mnew = __builtin_fmaxf(mhat, m); const float f = __builtin_amdgcn_exp2f(mhat - mnew); mhat = mnew; l_reg *= f;
      if (hi == 0) wsf[r32] = f;
      float sacc = 0.f;
#pragma unroll
      for (int r = 0; r < 16; ++r) { p0[r] = __builtin_amdgcn_exp2f(p0[r] - mnew); p1[r] = __builtin_amdgcn_exp2f(p1[r] - mnew); sacc += p0[r] + p1[r]; }
      l_reg += sacc;
      const u32x4 pw0 = {cvtpk_s(p0[0], p0[1]), cvtpk_s(p0[2], p0[3]), cvtpk_s(p0[4], p0[5]), cvtpk_s(p0[6], p0[7])};
      const u32x4 pw1 = {cvtpk_s(p0[8], p0[9]), cvtpk_s(p0[10], p0[11]), cvtpk_s(p0[12], p0[13]), cvtpk_s(p0[14], p0[15])};
      const u32x4 pw2 = {cvtpk_s(p1[0], p1[1]), cvtpk_s(p1[2], p1[3]), cvtpk_s(p1[4], p1[5]), cvtpk_s(p1[6], p1[7])};
      const u32x4 pw3 = {cvtpk_s(p1[8], p1[9]), cvtpk_s(p1[10], p1[11]), cvtpk_s(p1[12], p1[13]), cvtpk_s(p1[14], p1[15])};
      asm volatile("s_waitcnt lgkmcnt(0)" ::: "memory");
#pragma unroll
      for (int r = 0; r < 16; ++r) { const float fr_ = wsf[crow(r, hi)]; o[0][r] *= fr_; o[1][r] *= fr_; }
      ATT_SBAR();
      pv(o, vb0 + slot, __builtin_bit_cast(bf16x8, pw0), __builtin_bit_cast(bf16x8, pw1), __builtin_bit_cast(bf16x8, pw2), __builtin_bit_cast(bf16x8, pw3));
    }
    asm volatile("s_waitcnt lgkmcnt(0)\n\ts_barrier" ::: "memory");
  }
  { auto rr = __builtin_amdgcn_permlane32_swap(__float_as_uint(l_reg), __float_as_uint(l_reg), false, false); l_reg = __uint_as_float(rr[0]) + __uint_as_float(rr[1]); }
  if (hi == 0) wsf[32 + r32] = l_reg; asm volatile("s_waitcnt lgkmcnt(0)" ::: "memory");
  float rli[16];
#pragma unroll
  for (int r = 0; r < 16; ++r) rli[r] = __builtin_amdgcn_rcpf(wsf[32 + crow(r, hi)]);
  bf16_t* Ow = O + (rowbase + q0 + wid * 32) * OP + h * 64;
  { LDSH* stg = (LDSH*)(shm + L_OST) + wid * 2048;
#pragma unroll
    for (int r = 0; r < 16; ++r) { const int orow = crow(r, hi);
#pragma unroll
      for (int d0 = 0; d0 < 2; ++d0) stg[orow * 64 + d0 * 32 + r32] = f2bf1(o[d0][r] * rli[r]); }
    asm volatile("s_waitcnt lgkmcnt(0)" ::: "memory");
#pragma unroll
    for (int i = 0; i < 4; ++i) { const int row = i * 8 + (lane >> 3), ch = lane & 7; const u32x4 v = *(const __attribute__((address_space(3))) u32x4*)(stg + row * 64 + ch * 8); *(u32x4*)(Ow + (long)row * OP + ch * 8) = v; } }
  asm volatile("s_waitcnt vmcnt(0) lgkmcnt(0)\n\ts_barrier" ::: "memory");
#undef ATT_DMA_K
#undef ATT_DMA_V
}
}
#define GAS __attribute__((address_space(1)))
#define LAS __attribute__((address_space(3)))
typedef unsigned short bf16;
typedef unsigned v4u __attribute__((ext_vector_type(4)));
typedef unsigned v2u __attribute__((ext_vector_type(2)));
typedef float f32x4 __attribute__((ext_vector_type(4)));
typedef float f32x2 __attribute__((ext_vector_type(2)));
constexpr int NWAVES = 8, NTHR = 512;
constexpr int BATCH = 2, SEQ = 8192, DMODEL = 1024, MTOK = BATCH * SEQ, DFF = 2752, DFFP = 2816, N13 = 5632, INCOLS = 2304, MODC = 9216;
constexpr float EPS = 1e-6f;
constexpr size_t MiB = 1u << 20;
constexpr size_t WS_CTL = 0, CTL_ZERO_BYTES = 1 * MiB;
constexpr size_t WS_MVEC = 512 * 1024;
constexpr size_t WS_H3 = 2 * MiB;
constexpr size_t WS_W13 = 4 * MiB, W13_STRIDE = 11 * MiB;
constexpr size_t WS_W2T = 26 * MiB, W2T_STRIDE = 11 * MiB / 2;
constexpr size_t WS_WIN = 37 * MiB;
constexpr size_t WS_WOUT = WS_WIN + 9 * MiB / 2;
constexpr size_t WS_XN = 44 * MiB;
constexpr size_t WS_HID = 76 * MiB;
constexpr size_t WS_QN = 148 * MiB;
constexpr size_t WS_KN = 164 * MiB;
constexpr size_t WS_ZT = 168 * MiB;
constexpr size_t WS_KF = 200 * MiB;
constexpr size_t WS_END = 264 * MiB;
static_assert(WS_WOUT + 2 * MiB <= WS_XN && WS_HID + (size_t)MTOK * DFFP * 2 == WS_KN && WS_HID + (size_t)MTOK * INCOLS * 2 == WS_QN, "ws map");
constexpr int CW_BAR = 4096;
constexpr int LDS_BYTES = 147456;
constexpr int SCR_BYTES = 139264;
constexpr int MISC_OFF = 143360;
#define LDS_WAIT() asm volatile("s_waitcnt lgkmcnt(0)" ::: "memory")
#define VM_WAIT() asm volatile("s_waitcnt vmcnt(0)" ::: "memory")
__device__ __forceinline__ float bf_lo(unsigned v) { return __uint_as_float(v << 16); }
__device__ __forceinline__ float bf_hi(unsigned v) { return __uint_as_float(v & 0xffff0000u); }
__device__ __forceinline__ float bf1(unsigned short v) { return __uint_as_float((unsigned)v << 16); }
__device__ __forceinline__ unsigned pk2(float lo, float hi) { return att::cvtpk_s(lo, hi); }
__device__ __forceinline__ float wave_sum(float v) {
#pragma unroll
    for (int o = 1; o < 64; o <<= 1) v += __shfl_xor(v, o);
    return v;
}
template <class T> __device__ __forceinline__ T* uni_ptr(T* p) { const unsigned long long v = (unsigned long long)p; const unsigned lo = __builtin_amdgcn_readfirstlane((unsigned)v), hi = __builtin_amdgcn_readfirstlane((unsigned)(v >> 32)); return (T*)(((unsigned long long)hi << 32) | lo); }
__device__ __forceinline__ int uni_i(int v) { return __builtin_amdgcn_readfirstlane(v); }
#define XB_TMO      128
#define XB_XCNT(j)  (256  + 64 * (j))
#define XB_XSUB(j)  (1280 + 64 * (j))
#define XB_XGEN(j)  (2304 + 64 * (j))
#define XB_TOP      3328
#define XB_TOPGEN   3392
#define XCD_BAR_WORDS 3456
#define XB_SPIN_CAP (1u << 18)

__device__ __forceinline__ unsigned xb_ld(unsigned* p)              { return __hip_atomic_load(p, __ATOMIC_RELAXED, __HIP_MEMORY_SCOPE_AGENT); }
__device__ __forceinline__ unsigned xb_add(unsigned* p, unsigned v) { return __hip_atomic_fetch_add(p, v, __ATOMIC_RELAXED, __HIP_MEMORY_SCOPE_AGENT); }
__device__ __forceinline__ unsigned xb_xcc_id() { return (unsigned)__builtin_amdgcn_s_getreg((3 << 11) | 20) & 0xFu; }
#define XB_SPIN(cond, bar) do { unsigned _sp = 0; while (cond) { __builtin_amdgcn_s_sleep(1); \
    if ((++_sp & 255u) == 0u) { if (xb_ld(&(bar)[XB_TMO])) break; if (_sp > XB_SPIN_CAP) { atomicAdd(&(bar)[XB_TMO], 1u); break; } } } } while (0)

struct XcdBarrier {
    unsigned* bar; unsigned x;
    volatile LAS unsigned* st;
};

__device__ __forceinline__ XcdBarrier xcd_barrier_post(unsigned* bar, volatile LAS unsigned* st) {
    XcdBarrier b; b.bar = bar; b.x = xb_xcc_id(); b.st = st;
    if (threadIdx.x == 0) (void)xb_add(&bar[XB_XCNT(b.x)], 1u);
    return b;
}
__device__ __forceinline__ void xcd_barrier_complete(unsigned* bar, unsigned x, unsigned& nloc, unsigned& nx) {
    const unsigned G = gridDim.x * gridDim.y * gridDim.z;
    unsigned sum, cnt, mine, sp = 0u;
    for (;;) {
        sum = 0u; cnt = 0u; mine = 0u;
#pragma unroll
        for (unsigned j = 0; j < 16; ++j) { const unsigned c = xb_ld(&bar[XB_XCNT(j)]); sum += c; cnt += (c > 0u) ? 1u : 0u; mine = (j == x) ? c : mine; }
        if (sum == G) break;
        __builtin_amdgcn_s_sleep(1);
        if ((++sp & 255u) == 0u) { if (xb_ld(&bar[XB_TMO])) break; if (sp > XB_SPIN_CAP) { atomicAdd(&bar[XB_TMO], 1u); break; } }
    }
    nloc = mine > 0u ? mine : 1u; nx = cnt > 0u ? cnt : 1u;
}

__device__ __forceinline__ void xcd_barrier(const XcdBarrier& b) {
    asm volatile("s_waitcnt vmcnt(0)" ::: "memory");
    __syncthreads();
    if (threadIdx.x == 0) {
        unsigned* bar = b.bar;
        __builtin_amdgcn_s_waitcnt(0);
        unsigned nloc = b.st[0], nx = b.st[1];
        if (nloc == 0u) { xcd_barrier_complete(bar, b.x, nloc, nx); b.st[0] = nloc; b.st[1] = nx; }
        const unsigned old = xb_add(&bar[XB_XSUB(b.x)], 1u);
        const unsigned gen = old / nloc;
        if (old + 1u == (gen + 1u) * nloc) {
            __builtin_amdgcn_fence(__ATOMIC_RELEASE, "agent");
            asm volatile("s_waitcnt vmcnt(0)" ::: "memory");
            const unsigned og = xb_add(&bar[XB_TOP], 1u);
            const unsigned tg = og / nx;
            if (og + 1u == (tg + 1u) * nx) xb_add(&bar[XB_TOPGEN], 1u);
            else XB_SPIN(xb_ld(&bar[XB_TOPGEN]) == tg, bar);
            __builtin_amdgcn_fence(__ATOMIC_ACQUIRE, "agent");
            xb_add(&bar[XB_XGEN(b.x)], 1u);
            asm volatile("s_waitcnt vmcnt(0)" ::: "memory");
        } else {
            XB_SPIN(xb_ld(&bar[XB_XGEN(b.x)]) == gen, bar);
            __builtin_amdgcn_fence(__ATOMIC_ACQUIRE, "agent");
            asm volatile("s_waitcnt vmcnt(0)" ::: "memory");
        }
    }
    __syncthreads();
}
struct Args { const float* in[27]; float* out; unsigned char* ws; int ph_lo, ph_hi, use_cg, pad; };
struct Ctx {
    LAS unsigned char* lds; int tid, lane, wave, vcu, G;
    float* out; unsigned char* ws;
};
__device__ __forceinline__ void transpose_item(const float* W, int N, int k0, int n0src, bool valid, bf16* WT, size_t drow0, int Kd, LAS float* scr, int lane) {
    if (valid) {
#pragma unroll 8
        for (int i = 0; i < 32; ++i) { const int kk = 2 * i + (lane >> 5); scr[kk * 33 + (lane & 31)] = W[(size_t)(k0 + kk) * N + n0src + (lane & 31)]; }
    } else {
#pragma unroll 8
        for (int i = 0; i < 32; ++i) { const int kk = 2 * i + (lane >> 5); scr[kk * 33 + (lane & 31)] = 0.f; }
    }
    LDS_WAIT(); asm volatile("" ::: "memory");
    const int c = lane & 7;
#pragma unroll
    for (int j = 0; j < 4; ++j) { const int n = (lane >> 3) + 8 * j; const LAS float* s = scr + (8 * c) * 33 + n;
        v4u o; o.x = pk2(s[0 * 33], s[1 * 33]); o.y = pk2(s[2 * 33], s[3 * 33]); o.z = pk2(s[4 * 33], s[5 * 33]); o.w = pk2(s[6 * 33], s[7 * 33]);
        *(v4u*)(WT + (drow0 + n) * (size_t)Kd + k0 + 8 * c) = o; }
    LDS_WAIT(); asm volatile("" ::: "memory");
}
__device__ __forceinline__ void convert_weights(const Ctx& F, const Args& A, int l) {
    LAS float* scr = (LAS float*)(F.lds + F.wave * 16384);
    const int gw = F.vcu * NWAVES + F.wave, NGW = F.G * NWAVES;
    constexpr int I13 = 16 * 176, I2 = 44 * 32, IIN = 16 * 72, IOUT = 16 * 32, NIT = 2 * I13 + 2 * I2 + IIN + IOUT;
    for (int it = gw; it < NIT; it += NGW) {
        int r = it;
        if (r < 2 * I13) { const int f = r / I13; r -= f * I13; const int kb = r / 176, nb = r % 176, np = 32 * nb, pn = np >> 8, bj = (np >> 7) & 1, j0 = np & 127, sc = 128 * pn + j0;
            const float* src = (bj ? A.in[9] : A.in[8]) + (size_t)(l * 2 + f) * DMODEL * DFF;
            transpose_item(src, DFF, 64 * kb, sc, sc < DFF, (bf16*)(F.ws + WS_W13 + f * W13_STRIDE), (size_t)np, DMODEL, scr, F.lane); continue; }
        r -= 2 * I13;
        if (r < 2 * I2) { const int f = r / I2; r -= f * I2; const int kb = r / 32, nb = r % 32;
            const float* src = A.in[10] + (size_t)(l * 2 + f) * DFF * DMODEL;
            transpose_item(src, DMODEL, 64 * kb, 32 * nb, 64 * kb < DFF, (bf16*)(F.ws + WS_W2T + f * W2T_STRIDE), (size_t)(32 * nb), DFFP, scr, F.lane); continue; }
        r -= 2 * I2;
        if (r < IIN) { const int kb = r / 72, nb = r % 72; transpose_item(A.in[6] + (size_t)l * DMODEL * INCOLS, INCOLS, 64 * kb, 32 * nb, true, (bf16*)(F.ws + WS_WIN), (size_t)(32 * nb), DMODEL, scr, F.lane); continue; }
        r -= IIN;
        { const int kb = r / 32, nb = r % 32; transpose_item(A.in[7] + (size_t)l * DMODEL * DMODEL, DMODEL, 64 * kb, 32 * nb, true, (bf16*)(F.ws + WS_WOUT), (size_t)(32 * nb), DMODEL, scr, F.lane); }
    }
}
__device__ __forceinline__ void mod_gemv(const Ctx& F, const Args& A) {
    const int gw = F.vcu * NWAVES + F.wave, NGW = F.G * NWAVES;
    const float* c = A.in[1]; const float* wm = A.in[4]; const float* bm = A.in[5]; float* mv = (float*)(F.ws + WS_MVEC);
    for (int it = gw; it < 576; it += NGW) {
        const int l = it / 288, rem = it % 288, nc = rem >> 3, kc = rem & 7; const int n0 = nc * 256 + 4 * F.lane;
        f32x4 a0 = {0.f, 0.f, 0.f, 0.f}, a1 = {0.f, 0.f, 0.f, 0.f};
        const float* wp = wm + ((size_t)l * DMODEL + kc * 128) * MODC + n0;
#pragma unroll 4
        for (int k = 0; k < 128; ++k) { const f32x4 w = *(const f32x4*)(wp + (size_t)k * MODC);
            const float c0 = c[kc * 128 + k], c1 = c[DMODEL + kc * 128 + k];
            const float s0 = c0 / (1.f + __expf(-c0)), s1 = c1 / (1.f + __expf(-c1));
            a0 += w * s0; a1 += w * s1; }
        if (kc == 0) { const f32x4 bv = *(const f32x4*)(bm + (size_t)l * MODC + n0); a0 += bv; a1 += bv; }
        float* d0 = mv + (size_t)(l * 2 + 0) * MODC + n0; float* d1 = mv + (size_t)(l * 2 + 1) * MODC + n0;
#pragma unroll
        for (int e = 0; e < 4; ++e) { unsafeAtomicAdd(d0 + e, a0[e]); unsafeAtomicAdd(d1 + e, a1[e]); }
    }
}
__device__ __forceinline__ void hyena_h3(const Ctx& F, const Args& A) {
    const int gw = F.vcu * NWAVES + F.wave, NGW = F.G * NWAVES; const int j = F.lane;
    const float* w1 = A.in[18]; const float* b1 = A.in[19]; const float* w2 = A.in[20]; const float* b2 = A.in[21]; const float* w3 = A.in[22]; const float* b3 = A.in[23]; const float* fqp = A.in[25];
    float* H3 = (float*)(F.ws + WS_H3);
    const float fq = fqp[j], bb1 = b1[j], bb2 = b2[j], bb3 = b3[j];
    const int fi = (j >= 1 && j <= 32) ? ((j - 1) & 15) : 0; const float fr = 1e-4f + (float)fi * ((15.0f - 1e-4f) / 15.0f);
    for (int l = gw; l < SEQ; l += NGW) {
        const float t = (float)l * (1.0f / 8191.0f); const float w = (float)l * (float)(6.283185307179586 / 8192.0);
        const float arg = fr * w;
        float zv = (j == 0) ? t : (j <= 16 ? cosf(arg) : -sinf(arg));
        float a = bb1;
#pragma unroll
        for (int i = 0; i < 33; ++i) a += __shfl(zv, i) * w1[i * 64 + j];
        const float h1 = sinf(fq * a);
        a = bb2;
#pragma unroll 16
        for (int i = 0; i < 64; ++i) a += __shfl(h1, i) * w2[i * 64 + j];
        const float h2 = sinf(fq * a);
        a = bb3;
#pragma unroll 16
        for (int i = 0; i < 64; ++i) a += __shfl(h2, i) * w3[i * 64 + j];
        H3[(size_t)l * 64 + j] = sinf(fq * a);
    }
}
__device__ __forceinline__ void norm_phase(const Ctx& F, const Args& A, int l, int i) {
    const int gw = F.vcu * NWAVES + F.wave, NGW = F.G * NWAVES;
    const float* xin = (l == 0 && i == 0) ? A.in[0] : F.out; const float* g = A.in[3] + (size_t)(l * 3 + i) * DMODEL; const float* mv = (const float*)(F.ws + WS_MVEC);
    bf16* XN = (bf16*)(F.ws + WS_XN);
    for (int row = gw; row < MTOK; row += NGW) {
        const int b = row >> 13; const float* sh = mv + (size_t)(l * 2 + b) * MODC + i * 3072; const float* sc = sh + 1024;
        const f32x4* xr = (const f32x4*)(xin + (size_t)row * DMODEL) + F.lane;
        f32x4 v[4]; float s = 0.f;
#pragma unroll
        for (int j = 0; j < 4; ++j) { v[j] = xr[64 * j]; s += (v[j].x * v[j].x + v[j].y * v[j].y) + (v[j].z * v[j].z + v[j].w * v[j].w); }
        const float rstd = rsqrtf(wave_sum(s) * (1.f / DMODEL) + EPS);
        v2u* o8 = (v2u*)(XN + (size_t)row * DMODEL) + F.lane;
#pragma unroll
        for (int j = 0; j < 4; ++j) { const f32x4 gg = ((const f32x4*)g)[64 * j + F.lane], ss = ((const f32x4*)sc)[64 * j + F.lane], hh = ((const f32x4*)sh)[64 * j + F.lane];
            const f32x4 y = v[j] * rstd * gg * (ss + 1.0f) + hh; v2u w; w.x = pk2(y.x, y.y); w.y = pk2(y.z, y.w); o8[64 * j] = w; }
    }
}
__device__ __forceinline__ void prep_qk(const Ctx& F, const Args& A, int l) {
    const int gw = F.vcu * NWAVES + F.wave, NGW = F.G * NWAVES;
    const bf16* H = (const bf16*)(F.ws + WS_HID); bf16* QN = (bf16*)(F.ws + WS_QN); bf16* KN = (bf16*)(F.ws + WS_KN);
    const float* qkg = (l == 0) ? A.in[11] : A.in[15];
    const int i = F.lane & 31, hs = F.lane >> 5;
    const float gq0 = qkg[2 * i], gq1 = qkg[2 * i + 1], gk0 = qkg[64 + 2 * i], gk1 = qkg[64 + 2 * i + 1];
    const float inv = exp2f(-(float)(2 * (i & 15)) * (1.0f / 32.0f) * 13.287712379549449f);
    for (int row = gw; row < MTOK; row += NGW) {
        float cs = 1.f, sn = 0.f;
        if (l == 1) { const int t = row & (SEQ - 1); const float pos = (float)((i < 16) ? (t >> 6) : (t & 63)); const float ang = pos * inv; cs = cosf(ang); sn = sinf(ang); }
#pragma unroll
        for (int jj = 0; jj < 5; ++jj) { const int head = 2 * jj + hs;
            const unsigned v = *(const unsigned*)(H + (size_t)row * INCOLS + head * 64 + 2 * i);
            const float x0 = bf_lo(v), x1 = bf_hi(v);
            float ss = x0 * x0 + x1 * x1;
#pragma unroll
            for (int o = 1; o < 32; o <<= 1) ss += __shfl_xor(ss, o);
            const float rstd = rsqrtf(ss * (1.f / 64.f) + EPS);
            const bool isq = head < 8;
            float y0 = x0 * rstd * (isq ? gq0 : gk0), y1 = x1 * rstd * (isq ? gq1 : gk1);
            if (l == 1) { const float r0 = y0 * cs - y1 * sn, r1 = y0 * sn + y1 * cs; y0 = r0; y1 = r1; }
            if (isq) *(unsigned*)(QN + (size_t)row * 512 + head * 64 + 2 * i) = pk2(y0 * att::C2, y1 * att::C2);
            else *(unsigned*)(KN + (size_t)row * 128 + (head - 8) * 64 + 2 * i) = pk2(y0, y1); }
    }
}
__device__ __forceinline__ void prep_conv_l0(const Ctx& F, const Args& A) {
    const int gw = F.vcu * NWAVES + F.wave, NGW = F.G * NWAVES;
    const bf16* H = (const bf16*)(F.ws + WS_HID) + 768; bf16* MIX = (bf16*)(F.ws + WS_XN);
    const float* cw = A.in[13]; const float* cb = A.in[14];
    for (int it = gw; it < 2048; it += NGW) {
        const int row0 = (it >> 3) * 64, c = (it & 7) * 64 + F.lane, t0 = row0 & (SEQ - 1);
        const float w0 = cw[c], w1 = cw[512 + c], w2 = cw[1024 + c], bb = cb[c];
        const bf16* hp = H + (size_t)row0 * INCOLS + c;
        float vp = 0.f; if (t0 > 0) vp = bf1(hp[-(long)INCOLS + 512]) * bf1(hp[-(long)INCOLS + 1024]);
        float vc = bf1(hp[512]) * bf1(hp[1024]);
        for (int r = 0; r < 64; ++r) {
            float vn = 0.f; if (t0 + r + 1 < SEQ) vn = bf1(hp[(size_t)(r + 1) * INCOLS + 512]) * bf1(hp[(size_t)(r + 1) * INCOLS + 1024]);
            const float o = bf1(hp[(size_t)r * INCOLS]) * (w0 * vp + w1 * vc + w2 * vn + bb);
            MIX[(size_t)(row0 + r) * DMODEL + 512 + c] = att::f2bf1(o);
            vp = vc; vc = vn; }
    }
}
__device__ __forceinline__ void prep_conv_l1(const Ctx& F, const Args& A) {
    const int gw = F.vcu * NWAVES + F.wave, NGW = F.G * NWAVES;
    const bf16* H = (const bf16*)(F.ws + WS_HID) + 768; float* ZT = (float*)(F.ws + WS_ZT);
    const float* cw = A.in[16]; const float* cb = A.in[17];
    LAS float* tile = (LAS float*)(F.lds + F.wave * 16640);
    for (int it = gw; it < 2048; it += NGW) {
        const int row0 = (it >> 3) * 64, cg = (it & 7) * 64, c = cg + F.lane, t0 = row0 & (SEQ - 1);
        const int c1 = 512 + c, cv = 1024 + c;
        const float a0 = cw[c1], a1 = cw[1536 + c1], a2 = cw[3072 + c1], ab = cb[c1];
        const float v0 = cw[cv], v1 = cw[1536 + cv], v2 = cw[3072 + cv], vb = cb[cv];
        const bf16* hp = H + (size_t)row0 * INCOLS;
        float xp = 0.f, yp = 0.f; if (t0 > 0) { xp = bf1(hp[-(long)INCOLS + c1]); yp = bf1(hp[-(long)INCOLS + cv]); }
        float xc = bf1(hp[c1]), yc = bf1(hp[cv]);
        for (int r = 0; r < 64; ++r) {
            float xn = 0.f, yn = 0.f; if (t0 + r + 1 < SEQ) { xn = bf1(hp[(size_t)(r + 1) * INCOLS + c1]); yn = bf1(hp[(size_t)(r + 1) * INCOLS + cv]); }
            const float u1 = a0 * xp + a1 * xc + a2 * xn + ab, uv = v0 * yp + v1 * yc + v2 * yn + vb;
            tile[F.lane * 65 + r] = u1 * uv;
            xp = xc; xc = xn; yp = yc; yc = yn; }
        LDS_WAIT(); asm volatile("" ::: "memory");
#pragma unroll 8
        for (int cc = 0; cc < 64; ++cc) ZT[(size_t)(cg + cc) * MTOK + row0 + F.lane] = tile[cc * 65 + F.lane];
        LDS_WAIT(); asm volatile("" ::: "memory");
    }
}
__device__ __forceinline__ void post_l1(const Ctx& F, const Args& A) {
    const int gw = F.vcu * NWAVES + F.wave, NGW = F.G * NWAVES;
    const bf16* H = (const bf16*)(F.ws + WS_HID) + 768; const float* YT = (const float*)(F.ws + WS_ZT); bf16* MIX = (bf16*)(F.ws + WS_XN);
    const float* cw = A.in[16]; const float* cb = A.in[17];
    LAS float* tile = (LAS float*)(F.lds + F.wave * 16640);
    for (int it = gw; it < 2048; it += NGW) {
        const int row0 = (it >> 3) * 64, cg = (it & 7) * 64, c = cg + F.lane, t0 = row0 & (SEQ - 1);
#pragma unroll 8
        for (int cc = 0; cc < 64; ++cc) tile[cc * 65 + F.lane] = YT[(size_t)(cg + cc) * MTOK + row0 + F.lane];
        LDS_WAIT(); asm volatile("" ::: "memory");
        const float a0 = cw[c], a1 = cw[1536 + c], a2 = cw[3072 + c], ab = cb[c];
        const bf16* hp = H + (size_t)row0 * INCOLS + c;
        float xp = 0.f; if (t0 > 0) xp = bf1(hp[-(long)INCOLS]);
        float xc = bf1(hp[0]);
        for (int r = 0; r < 64; ++r) {
            float xn = 0.f; if (t0 + r + 1 < SEQ) xn = bf1(hp[(size_t)(r + 1) * INCOLS]);
            const float u0 = a0 * xp + a1 * xc + a2 * xn + ab;
            MIX[(size_t)(row0 + r) * DMODEL + 512 + c] = att::f2bf1(u0 * tile[F.lane * 65 + r]);
            xp = xc; xc = xn; }
        LDS_WAIT(); asm volatile("" ::: "memory");
    }
}
__device__ __forceinline__ void fft_sincos2pi(float f, float& s, float& c) { s = sinpif(2.0f * f); c = cospif(2.0f * f); }
#define FFT_HD __device__ __forceinline__
#define FFT_OPAQUE(x) asm volatile("" : "+v"(x))
#define FFT_NOUNROLL _Pragma("unroll 1")
#ifndef FFT_HD
#define FFT_HD static inline
#endif
struct cf { float x, y; };
FFT_HD cf cmk(float x, float y) { cf r; r.x = x; r.y = y; return r; }
FFT_HD cf cadd(cf a, cf b) { return cmk(a.x + b.x, a.y + b.y); }
FFT_HD cf csub(cf a, cf b) { return cmk(a.x - b.x, a.y - b.y); }
FFT_HD cf cmul(cf a, cf b) { return cmk(a.x * b.x - a.y * b.y, a.x * b.y + a.y * b.x); }
FFT_HD cf cmulc(cf a, cf b) { return cmk(a.x * b.x + a.y * b.y, a.y * b.x - a.x * b.y); }
#ifndef FFT_OPAQUE
#define FFT_OPAQUE(x)
#define FFT_NOUNROLL
#endif
#define FFT_PAD(i) ((i) + (((i) >> 6) << 2))
constexpr int FFT_N = 16384;
constexpr int FFT_LDS_ELEMS = FFT_N + (FFT_N >> 6) * 4;

template <bool INV> FFT_HD void dft4(cf& a, cf& b, cf& c, cf& d) {
    const cf s0 = cadd(a, c), s1 = csub(a, c), s2 = cadd(b, d), s3 = csub(b, d);
    a = cadd(s0, s2); c = csub(s0, s2);
    if (!INV) { b = cmk(s1.x + s3.y, s1.y - s3.x); d = cmk(s1.x - s3.y, s1.y + s3.x); }
    else      { b = cmk(s1.x - s3.y, s1.y + s3.x); d = cmk(s1.x + s3.y, s1.y - s3.x); }
}
template <bool INV, int M> FFT_HD cf tw16(cf v) {
    constexpr float C1 = 0.92387953251128674f, S1 = 0.38268343236508977f, R = 0.70710678118654752f;
    float c, s;
    if (M == 0) return v;
    if (M == 1) { c = C1; s = S1; } else if (M == 2) { c = R; s = R; } else if (M == 3) { c = S1; s = C1; }
    else if (M == 4) { c = 0.f; s = 1.f; } else if (M == 6) { c = -R; s = R; } else   { c = -C1; s = -S1; }
    const cf w = cmk(c, INV ? s : -s);
    return cmul(v, w);
}
template <bool INV> FFT_HD void dft16(cf (&r)[16]) {
    dft4<INV>(r[0], r[4], r[8], r[12]); dft4<INV>(r[1], r[5], r[9], r[13]); dft4<INV>(r[2], r[6], r[10], r[14]); dft4<INV>(r[3], r[7], r[11], r[15]);
    r[5] = tw16<INV, 1>(r[5]); r[6] = tw16<INV, 2>(r[6]); r[7] = tw16<INV, 3>(r[7]);
    r[9] = tw16<INV, 2>(r[9]); r[10] = tw16<INV, 4>(r[10]); r[11] = tw16<INV, 6>(r[11]);
    r[13] = tw16<INV, 3>(r[13]); r[14] = tw16<INV, 6>(r[14]); r[15] = tw16<INV, 9>(r[15]);
    dft4<INV>(r[0], r[1], r[2], r[3]); dft4<INV>(r[4], r[5], r[6], r[7]); dft4<INV>(r[8], r[9], r[10], r[11]); dft4<INV>(r[12], r[13], r[14], r[15]);
}
#define FFT_XJ(r, j) r[4 * ((j) & 3) + ((j) >> 2)]

template <bool INV, int PS, class Mem> FFT_HD void r16_butterfly(const Mem& mem, int pb, float frac) {
    cf r[16];
#pragma unroll
    for (int k = 0; k < 16; ++k) r[k] = mem.ld(pb + PS * k);
    float s1, c1; fft_sincos2pi(frac, s1, c1);
    const cf w1 = cmk(c1, INV ? s1 : -s1);
    cf w[16];
    w[1] = w1; w[2] = cmul(w1, w1); w[3] = cmul(w[2], w1); w[4] = cmul(w[2], w[2]); w[5] = cmul(w[4], w1); w[6] = cmul(w[4], w[2]); w[7] = cmul(w[4], w[3]);
    w[8] = cmul(w[4], w[4]); w[9] = cmul(w[8], w1); w[10] = cmul(w[8], w[2]); w[11] = cmul(w[8], w[3]); w[12] = cmul(w[8], w[4]); w[13] = cmul(w[8], w[5]); w[14] = cmul(w[8], w[6]); w[15] = cmul(w[8], w[7]);
    if (INV) {
#pragma unroll
        for (int j = 1; j < 16; ++j) r[j] = cmul(r[j], w[j]);
        dft16<true>(r);
#pragma unroll
        for (int k = 0; k < 16; ++k) mem.st(pb + PS * k, FFT_XJ(r, k));
    } else {
        dft16<false>(r);
#pragma unroll
        for (int j = 0; j < 16; ++j) { cf v = FFT_XJ(r, j); if (j) v = cmul(v, w[j]); mem.st(pb + PS * j, v); }
    }
}
template <bool INV, class Mem> FFT_HD void r4_butterfly(const Mem& mem, int id) {
    const int pb = FFT_PAD(4 * id);
    cf a = mem.ld(pb), b = mem.ld(pb + 1), c = mem.ld(pb + 2), d = mem.ld(pb + 3);
    dft4<INV>(a, b, c, d);
    mem.st(pb, a); mem.st(pb + 1, b); mem.st(pb + 2, c); mem.st(pb + 3, d);
}
template <int P, class Mem> FFT_HD void fft_fwd_pass(const Mem& mem, int tid) {
    FFT_OPAQUE(tid);
    if (P == 0) { FFT_NOUNROLL for (int i = 0; i < 2; ++i) { const int id = tid + 512 * i; r16_butterfly<false, 1088>(mem, FFT_PAD(id), (float)id * (1.0f / 16384.0f)); } }
    else if (P == 1) { FFT_NOUNROLL for (int i = 0; i < 2; ++i) { const int id = tid + 512 * i, blk = id >> 6, n = id & 63; r16_butterfly<false, 68>(mem, FFT_PAD(blk * 1024 + n), (float)n * (1.0f / 1024.0f)); } }
    else if (P == 2) { FFT_NOUNROLL for (int i = 0; i < 2; ++i) { const int id = tid + 512 * i, blk = id >> 2, n = id & 3; r16_butterfly<false, 4>(mem, FFT_PAD(blk * 64 + n), (float)n * (1.0f / 64.0f)); } }
    else { FFT_NOUNROLL for (int i = 0; i < 8; ++i) r4_butterfly<false>(mem, tid + 512 * i); }
}
template <int P, class Mem> FFT_HD void fft_inv_pass(const Mem& mem, int tid) {
    FFT_OPAQUE(tid);
    if (P == 0) { FFT_NOUNROLL for (int i = 0; i < 8; ++i) r4_butterfly<true>(mem, tid + 512 * i); }
    else if (P == 1) { FFT_NOUNROLL for (int i = 0; i < 2; ++i) { const int id = tid + 512 * i, blk = id >> 2, n = id & 3; r16_butterfly<true, 4>(mem, FFT_PAD(blk * 64 + n), (float)n * (1.0f / 64.0f)); } }
    else if (P == 2) { FFT_NOUNROLL for (int i = 0; i < 2; ++i) { const int id = tid + 512 * i, blk = id >> 6, n = id & 63; r16_butterfly<true, 68>(mem, FFT_PAD(blk * 1024 + n), (float)n * (1.0f / 1024.0f)); } }
    else { FFT_NOUNROLL for (int i = 0; i < 2; ++i) { const int id = tid + 512 * i; r16_butterfly<true, 1088>(mem, FFT_PAD(id), (float)id * (1.0f / 16384.0f)); } }
}

struct LdsMem { LAS f32x2* p; __device__ __forceinline__ cf ld(int i) const { const f32x2 v = p[i]; return cmk(v.x, v.y); } __device__ __forceinline__ void st(int i, cf v) const { p[i] = (f32x2){v.x, v.y}; } };
#define WG_BAR() do { asm volatile("s_waitcnt vmcnt(0) lgkmcnt(0)" ::: "memory"); __builtin_amdgcn_s_barrier(); asm volatile("" ::: "memory"); } while (0)
__device__ __forceinline__ void fft_forward(const LdsMem& mem, int tid) {
    fft_fwd_pass<0>(mem, tid); WG_BAR(); fft_fwd_pass<1>(mem, tid); WG_BAR(); fft_fwd_pass<2>(mem, tid); WG_BAR(); fft_fwd_pass<3>(mem, tid); WG_BAR();
}
__device__ __forceinline__ void fft_inverse(const LdsMem& mem, int tid) {
    fft_inv_pass<0>(mem, tid); WG_BAR(); fft_inv_pass<1>(mem, tid); WG_BAR(); fft_inv_pass<2>(mem, tid); WG_BAR(); fft_inv_pass<3>(mem, tid); WG_BAR();
}
__device__ __forceinline__ void hyena_filter_item(const Ctx& F, const Args& A, int item) {
    const float* H3 = (const float*)(F.ws + WS_H3); const float* w4 = A.in[24]; cf* KF = (cf*)(F.ws + WS_KF);
    LdsMem mem; mem.p = (LAS f32x2*)F.lds;
    LAS float* wl = (LAS float*)(F.lds + MISC_OFF + 1024);
    LAS float* red = (LAS float*)(F.lds + MISC_OFF + 256);
    const int tid = F.tid; const int cA = item, cB = item + 256;
    if (tid < 256) { const int q = tid >> 6, j = tid & 63; const int col = (q & 1) * 512 + ((q >> 1) ? cB : cA); wl[q * 64 + j] = w4[j * 1024 + col]; }
    WG_BAR();
    const float dA = 15.350567286626973f - (float)cA * (12.280453829301578f / 511.0f), dB = 15.350567286626973f - (float)cB * (12.280453829301578f / 511.0f);
    float ssA = 0.f, ssB = 0.f; float* tmpB = (float*)(KF + (size_t)cB * FFT_N);
#pragma unroll 1
    for (int i = 0; i < 16; ++i) {
        const int l = tid + 512 * i; const f32x4* hr = (const f32x4*)(H3 + (size_t)l * 64);
        float s0 = 0.f, s1 = 0.f, s2 = 0.f, s3 = 0.f;
#pragma unroll
        for (int j4 = 0; j4 < 16; ++j4) { const f32x4 h = hr[j4];
            const f32x4 wa = ((const LAS f32x4*)wl)[j4], wb = ((const LAS f32x4*)wl)[16 + j4], wc = ((const LAS f32x4*)wl)[32 + j4], wd = ((const LAS f32x4*)wl)[48 + j4];
            s0 += h.x * wa.x + h.y * wa.y + h.z * wa.z + h.w * wa.w; s1 += h.x * wb.x + h.y * wb.y + h.z * wb.z + h.w * wb.w;
            s2 += h.x * wc.x + h.y * wc.y + h.z * wc.z + h.w * wc.w; s3 += h.x * wd.x + h.y * wd.y + h.z * wd.z + h.w * wd.w; }
        const float t = (float)l * (1.0f / 8191.0f); const float eA = __expf(-t * dA), eB = __expf(-t * dB);
        const float fA = s0 * eA, bA = (l > 0) ? s1 * eA : 0.f, fB = s2 * eB, bB = (l > 0) ? s3 * eB : 0.f;
        ssA += fA * fA + bA * bA; ssB += fB * fB + bB * bB;
        mem.st(FFT_PAD(l), cmk(fA, 0.f)); mem.st(FFT_PAD(l > 0 ? FFT_N - l : 8192), cmk(bA, 0.f));
        tmpB[l] = fB; tmpB[8192 + l] = bB;
    }
    ssA = wave_sum(ssA); ssB = wave_sum(ssB);
    if (F.lane == 0) { red[F.wave] = ssA; red[8 + F.wave] = ssB; }
    WG_BAR();
    float tA = 0.f, tB = 0.f;
#pragma unroll
    for (int w = 0; w < 8; ++w) { tA += red[w]; tB += red[8 + w]; }
    const float scA = rsqrtf(tA + EPS) * (1.0f / 16384.0f), scB = rsqrtf(tB + EPS) * (1.0f / 16384.0f);
#pragma unroll 1
    for (int ch = 0; ch < 2; ++ch) {
        if (ch == 1) {
#pragma unroll 4
            for (int i = 0; i < 16; ++i) { const int l = tid + 512 * i; const float fB = tmpB[l], bB = tmpB[8192 + l]; mem.st(FFT_PAD(l), cmk(fB, 0.f)); mem.st(FFT_PAD(l > 0 ? FFT_N - l : 8192), cmk(bB, 0.f)); }
            WG_BAR();
        }
        fft_forward(mem, tid);
        const float sc = ch ? scB : scA; cf* dst = KF + (size_t)(ch ? cB : cA) * FFT_N;
#pragma unroll 4
        for (int i = 0; i < 32; ++i) { const int p = tid + 512 * i; const cf v = mem.ld(FFT_PAD(p)); dst[p] = cmk(v.x * sc, v.y * sc); }
        WG_BAR();
    }
}
__device__ __forceinline__ void hyena_conv_item(const Ctx& F, const Args& A, int c) {
    float* ZT = (float*)(F.ws + WS_ZT) + (size_t)c * MTOK; const cf* KF = (const cf*)(F.ws + WS_KF) + (size_t)c * FFT_N; const float skip = A.in[26][c];
    LdsMem mem; mem.p = (LAS f32x2*)F.lds; const int tid = F.tid;
#pragma unroll 4
    for (int i = 0; i < 16; ++i) { const int t = tid + 512 * i; mem.st(FFT_PAD(t), cmk(ZT[t], ZT[SEQ + t])); mem.st(FFT_PAD(SEQ + t), cmk(0.f, 0.f)); }
    WG_BAR();
    fft_forward(mem, tid);
#pragma unroll 4
    for (int i = 0; i < 32; ++i) { const int p = tid + 512 * i; const cf k = KF[p]; mem.st(FFT_PAD(p), cmul(mem.ld(FFT_PAD(p)), k)); }
    WG_BAR();
    fft_inverse(mem, tid);
#pragma unroll 4
    for (int i = 0; i < 16; ++i) { const int t = tid + 512 * i; const cf v = mem.ld(FFT_PAD(t)); const float z0 = ZT[t], z1 = ZT[SEQ + t]; ZT[t] = v.x + skip * z0; ZT[SEQ + t] = v.y + skip * z1; }
    WG_BAR();
}
#ifndef PH_MASK
#define PH_MASK 0xFFFF
#endif
constexpr int NPHASE = 25;
__global__ void __launch_bounds__(NTHR, 2) mk_fwd(Args args) {
    extern __shared__ __attribute__((aligned(16))) unsigned char lds_raw[];
    Ctx F;
    F.lds = (LAS unsigned char*)lds_raw;
    F.tid = threadIdx.x; F.lane = F.tid & 63; F.wave = __builtin_amdgcn_readfirstlane(F.tid >> 6);
    F.G = gridDim.x; { const int bx = blockIdx.x; F.vcu = (F.G % 8 == 0) ? (bx % 8) * (F.G / 8) + bx / 8 : bx; }
    F.out = args.out; F.ws = args.ws;
    volatile LAS unsigned* MISC = (volatile LAS unsigned*)(F.lds + MISC_OFF);
    for (int u = F.tid; u < 64; u += NTHR) MISC[u] = 0u;
    __syncthreads();
    const int lo = args.ph_lo, hi = args.ph_hi;
    const bool multi = (hi - lo) > 1;
    XcdBarrier bar; bar.bar = (unsigned*)(F.ws + WS_CTL) + CW_BAR; bar.x = 0; bar.st = nullptr;
    if (multi) bar = xcd_barrier_post((unsigned*)(F.ws + WS_CTL) + CW_BAR, MISC + 8);
    if (args.use_cg) cooperative_groups::this_grid().sync();
    const Ctx F0 = F;
    for (int p = lo; p < hi; ++p) {
        if (p == 8) continue;
        const __attribute__((address_space(4))) Args* ap = (const __attribute__((address_space(4))) Args*)__builtin_amdgcn_kernarg_segment_ptr(); asm volatile("" : "+s"(ap)); const Args& A = *(const Args*)ap;
        Ctx F = F0; F.tid = threadIdx.x; asm volatile("" : "+v"(F.tid)); asm volatile("" : "+s"(F.vcu)); asm volatile("" : "+s"(F.G)); asm volatile("" : "+s"(F.out)); asm volatile("" : "+s"(F.ws)); F.lane = F.tid & 63; F.wave = __builtin_amdgcn_readfirstlane(F.tid >> 6);
        if (p == 0) { if constexpr ((PH_MASK & 1) != 0) { convert_weights(F, A, 0); mod_gemv(F, A); hyena_h3(F, A); } }
        else {
            const int l = (p - 1) / 12, s = (p - 1) % 12;
            const float* mv = uni_ptr((const float*)(F.ws + WS_MVEC) + (size_t)l * 2 * MODC);
            if (s == 0 || s == 3 || s == 9) { if constexpr ((PH_MASK & 2) != 0) { if (s == 0 && l == 1) convert_weights(F, A, 1); norm_phase(F, A, l, s / 3 > 2 ? 2 : s / 3); } }
            else if (s == 1 || s == 10 || s == 2 || s == 11 || s == 8 || s == 4) { if constexpr ((PH_MASK & 4) != 0) {
                pg8::Gemm g; pg8::EpiAny E; E.kind = 0; E.eb = pg8::EpiBf16{nullptr, 0}; E.es = pg8::EpiSwiglu{nullptr, 0}; E.er = pg8::EpiRes{nullptr, nullptr, 0, nullptr, 0, 0.f};
                if (s == 1 || s == 10) { const int f = s == 10; g = pg8::Gemm{(const bf16*)(F.ws + WS_XN), (const bf16*)(F.ws + WS_W13 + f * W13_STRIDE), MTOK, N13, DMODEL}; E.kind = 1; E.es = pg8::EpiSwiglu{(bf16*)(F.ws + WS_HID), DFFP}; }
                else if (s == 4) { g = pg8::Gemm{(const bf16*)(F.ws + WS_XN), (const bf16*)(F.ws + WS_WIN), MTOK, INCOLS, DMODEL}; E.kind = 0; E.eb = pg8::EpiBf16{(bf16*)(F.ws + WS_HID), INCOLS}; }
                else if (s == 8) { g = pg8::Gemm{(const bf16*)(F.ws + WS_XN), (const bf16*)(F.ws + WS_WOUT), MTOK, DMODEL, DMODEL}; E.kind = 2; E.er = pg8::EpiRes{F.out, F.out, DMODEL, mv + 1 * 3072 + 2048, MODC, 1.0f}; }
                else { const int f = s == 11; g = pg8::Gemm{(const bf16*)(F.ws + WS_HID), (const bf16*)(F.ws + WS_W2T + f * W2T_STRIDE), MTOK, DMODEL, DFFP}; E.kind = 2;
                    E.er = pg8::EpiRes{(l == 0 && f == 0) ? A.in[0] : F.out, F.out, DMODEL, mv + (f ? 2 : 0) * 3072 + 2048, MODC, 0.5f}; }
                g.A = uni_ptr(g.A); g.Bt = uni_ptr(g.Bt); g.N = uni_i(g.N); g.K = uni_i(g.K); E.kind = uni_i(E.kind);
                E.eb.O = uni_ptr(E.eb.O); E.eb.ldc = uni_i(E.eb.ldc); E.es.O = uni_ptr(E.es.O); E.es.ldc = uni_i(E.es.ldc);
                E.er.base = uni_ptr(E.er.base); E.er.out = uni_ptr(E.er.out); E.er.gate = uni_ptr(E.er.gate); E.er.ldc = uni_i(E.er.ldc); E.er.gstride = uni_i(E.er.gstride);
                pg8::StaticOrder S; S.init(MTOK, g.N, F.G, (int)blockIdx.x);
                pg8::gemm_phase<pg8::EpiAny, pg8::StaticOrder, true, true>(F.lds, g, S, E); } }
            else if (s == 5) { if constexpr ((PH_MASK & 32) != 0) { prep_qk(F, A, l); if (l == 0) prep_conv_l0(F, A); else prep_conv_l1(F, A); } }
            else if (s == 6) { if constexpr ((PH_MASK & 64) != 0) {
                const bf16* QN = (const bf16*)(F.ws + WS_QN); const bf16* KN = (const bf16*)(F.ws + WS_KN); const bf16* V = (const bf16*)(F.ws + WS_HID) + 640; bf16* MIX = (bf16*)(F.ws + WS_XN);
                if constexpr ((PH_MASK & 256) != 0)
#pragma unroll 1
                for (int i = 0; i < 2; ++i) { const int u = F.vcu * 2 + i, bh = u >> 5, qb = u & 31, b = bh >> 3, h = bh & 7;
                    att::attn_unit(l == 0, b, h, qb, QN, KN, V, MIX, (att::lds_ptr)F.lds, A.in[2], l == 0 ? A.in[12][h] * att::LOG2E : 0.f); }
                if constexpr ((PH_MASK & 512) != 0) if (l == 0) { hyena_filter_item(F, A, F.vcu); }
                if constexpr ((PH_MASK & 1024) != 0) if (l == 1) {
#pragma unroll 1
                    for (int k = 0; k < 2; ++k) hyena_conv_item(F, A, F.vcu + 256 * k); } } }
            else if (s == 7) { if constexpr ((PH_MASK & 128) != 0) { post_l1(F, A); } }
        }
        if (p + 1 < hi) { XcdBarrier b2 = bar; asm volatile("" : "+s"(b2.bar)); asm volatile("" : "+s"(b2.x)); xcd_barrier(b2); }
    }
}

extern "C" void kernel_launch(void* const* d_in, const int* in_sizes, int n_in, void* d_out, int out_size, void* d_ws, size_t ws_size, hipStream_t stream) {
    static int grid = 0;
    if (grid == 0) {
        if (n_in != 27 || out_size != MTOK * DMODEL || ws_size < WS_END) { fprintf(stderr, "kernel_launch: unexpected problem (n_in %d, out %d, ws %zu)\n", n_in, out_size, ws_size); grid = -1; return; }
        int dev = 0, cus = 0, per_cu = 0;
        if (hipGetDevice(&dev) != hipSuccess || hipDeviceGetAttribute(&cus, hipDeviceAttributeMultiprocessorCount, dev) != hipSuccess) { grid = -1; return; }
        if (hipFuncSetAttribute((const void*)mk_fwd, hipFuncAttributeMaxDynamicSharedMemorySize, LDS_BYTES) != hipSuccess) { fprintf(stderr, "kernel_launch: hipFuncSetAttribute failed\n"); grid = -1; return; }
        if (hipOccupancyMaxActiveBlocksPerMultiprocessor(&per_cu, (const void*)mk_fwd, NTHR, LDS_BYTES) != hipSuccess || per_cu < 1) { fprintf(stderr, "kernel_launch: occupancy query says %d blocks per CU\n", per_cu); per_cu = 1; }
        (void)hipGetLastError();
        grid = cus;
        if (grid != 256) fprintf(stderr, "kernel_launch: %d CUs (tuned for 256)\n", grid);
    }
    if (grid < 0) return;
    (void)hipMemsetAsync((char*)d_ws + WS_CTL, 0, CTL_ZERO_BYTES, stream);
    Args a{};
    for (int i = 0; i < 27; ++i) a.in[i] = (const float*)d_in[i];
    a.out = (float*)d_out; a.ws = (unsigned char*)d_ws; a.use_cg = 0; a.pad = 0;
#if MK_SINGLE
    a.ph_lo = 0; a.ph_hi = NPHASE;
    void* kargs[] = {&a};
    hipError_t e = hipLaunchCooperativeKernel((const void*)mk_fwd, dim3(grid), dim3(NTHR), kargs, LDS_BYTES, stream);
    if (e != hipSuccess) fprintf(stderr, "cooperative launch failed: %s (grid %d)\n", hipGetErrorString(e), grid);
#else
    for (int p = 0; p < NPHASE; ++p) { if (p == 8) continue; a.ph_lo = p; a.ph_hi = p + 1; hipLaunchKernelGGL(mk_fwd, dim3(grid), dim3(NTHR), LDS_BYTES, stream, a); }
#endif
}
```

```cpp
#include <hip/hip_runtime.h>
#include <hip/hip_cooperative_groups.h>
#include <cstdio>
#include <cstdint>
#include <cmath>
#include <hip/hip_bf16.h>
#define MK_SINGLE 1
namespace pg8 {
#define PG8_LAS __attribute__((address_space(3)))
typedef unsigned short bf16_t;
typedef short bf16x8 __attribute__((ext_vector_type(8)));
typedef float f32x4 __attribute__((ext_vector_type(4)));
typedef unsigned u32x4 __attribute__((ext_vector_type(4)));
constexpr int BM = 256, BK = 64, HALF = 128, HTB = HALF * BK * 2  , STAGE_BYTES = 8 * HTB, NXCD = 8, WGM = 8;

__host__ __device__ __forceinline__ int lds_byte(int r, int c) { const int st = (r >> 4) * 2 + (c >> 5), rr = r & 15, cc = c & 31, ob = rr * 64 + cc * 2; return st * 1024 + (ob ^ (((ob >> 9) & 1) << 5)); }
__host__ __device__ __forceinline__ void stage_rc(int b, int& R, int& C) { const int st = b / 1024, sb = b % 1024, swz = sb ^ (((sb >> 9) & 1) << 5); R = (st >> 1) * 16 + swz / 64; C = (st & 1) * 32 + (swz % 64) / 2; }
__host__ __device__ __forceinline__ int perm32(int rho) { const int n = rho >> 4, i = rho & 15; return 8 * (i >> 2) + 4 * n + (i & 3); }

struct Unit { int pm, pn; };
struct Gemm { const bf16_t* A; const bf16_t* Bt; int M, N, K; };

struct StaticOrder {
    int nM, nN, nwg, G, c;
    __host__ __device__ void init(int M, int N, int G_, int c_) { nM = M / BM; nN = N / BM; nwg = nM * nN; G = G_; c = c_; }
    __host__ __device__ bool next(int i, Unit& u) const {
        const long L = (long)i * G + c; if (L >= nwg) return false;
        int wgid = (int)L; { const int q = nwg / NXCD, r = nwg % NXCD, xcd = wgid % NXCD, off = wgid / NXCD; wgid = (xcd < r ? xcd * (q + 1) : r * (q + 1) + (xcd - r) * q) + off; }
        const int nig = WGM * nN, gid = wgid / nig, fm = gid * WGM, gsz = (nM - fm) < WGM ? (nM - fm) : WGM;
        u.pm = fm + ((wgid % nig) % gsz); u.pn = (wgid % nig) / gsz; return true;
    }
    __device__ __forceinline__ void a_ready(const Unit&) const {}
    __device__ __forceinline__ void done(const Unit&) const {}
};

__device__ __forceinline__ unsigned cvt_pk_bf16(float lo, float hi) { unsigned r; asm volatile("v_cvt_pk_bf16_f32 %0, %1, %2" : "=v"(r) : "v"(lo), "v"(hi)); return r; }
typedef float f32x2 __attribute__((ext_vector_type(2)));
typedef float f32x2 __attribute__((ext_vector_type(2)));
__device__ __forceinline__ float silu_mul(float g, float u) { const float e = __builtin_amdgcn_exp2f(g * (-1.4426950408889634f)); return g * __builtin_amdgcn_rcpf(1.0f + e) * u; }
struct EpiBf16 {
    static constexpr bool PERM = true, AFTER_DRAIN = false;
    bf16_t* O; int ldc;
    __device__ __forceinline__ void operator()(const f32x4 (&acc)[2][2][4][2], const Unit& u, int wr, int wc, int fr, int fq) const {
        const int row0 = u.pm * BM + wr * 64 + fr; const int col0 = u.pn * BM + wc * 32 + 8 * fq;
#pragma unroll
        for (int ai = 0; ai < 2; ++ai)
#pragma unroll
            for (int m = 0; m < 4; ++m) { bf16_t* rowp = O + (size_t)(row0 + ai * HALF + m * 16) * ldc + col0;
#pragma unroll
                for (int bj = 0; bj < 2; ++bj) { const f32x4 v0 = acc[ai][bj][m][0], v1 = acc[ai][bj][m][1];
                    u32x4 w; w.x = cvt_pk_bf16(v0[0], v0[1]); w.y = cvt_pk_bf16(v0[2], v0[3]); w.z = cvt_pk_bf16(v1[0], v1[1]); w.w = cvt_pk_bf16(v1[2], v1[3]);
                    *(u32x4*)(rowp + bj * HALF) = w; } }
    }
};
struct EpiSwiglu {
    static constexpr bool PERM = true, AFTER_DRAIN = false;
    bf16_t* O; int ldc; int i8; const float* sA; const float* sW;
    __device__ __forceinline__ void operator()(const f32x4 (&acc)[2][2][4][2], const Unit& u, int wr, int wc, int fr, int fq) const {
        const int row0 = u.pm * BM + wr * 64 + fr; const int col0 = u.pn * HALF + wc * 32 + 8 * fq;
        f32x4 sw[2][2];
        if (i8) {
#pragma unroll
            for (int bj = 0; bj < 2; ++bj)
#pragma unroll
                for (int n = 0; n < 2; ++n) sw[bj][n] = *(const f32x4*)(sW + u.pn * BM + bj * HALF + wc * 32 + 8 * fq + 4 * n);
        }
#pragma unroll
        for (int ai = 0; ai < 2; ++ai)
#pragma unroll
            for (int m = 0; m < 4; ++m) { const int row = row0 + ai * HALF + m * 16;
                f32x4 g0 = acc[ai][0][m][0], g1 = acc[ai][0][m][1], u0 = acc[ai][1][m][0], u1 = acc[ai][1][m][1];
                if (i8) { const float sa = sA[row];
#define PG8_I2F(v, s) ((i8 == 2) ? v : (f32x4){(float)__float_as_int(v.x), (float)__float_as_int(v.y), (float)__float_as_int(v.z), (float)__float_as_int(v.w)}) * (s * sa)
                    g0 = PG8_I2F(g0, sw[0][0]); g1 = PG8_I2F(g1, sw[0][1]); u0 = PG8_I2F(u0, sw[1][0]); u1 = PG8_I2F(u1, sw[1][1]);
#undef PG8_I2F
                }
                u32x4 w; w.x = cvt_pk_bf16(silu_mul(g0[0], u0[0]), silu_mul(g0[1], u0[1])); w.y = cvt_pk_bf16(silu_mul(g0[2], u0[2]), silu_mul(g0[3], u0[3]));
                w.z = cvt_pk_bf16(silu_mul(g1[0], u1[0]), silu_mul(g1[1], u1[1])); w.w = cvt_pk_bf16(silu_mul(g1[2], u1[2]), silu_mul(g1[3], u1[3]));
                *(u32x4*)(O + (size_t)row * ldc + col0) = w; }
    }
};
struct EpiRes {
    static constexpr bool PERM = true, AFTER_DRAIN = false;
    const float* base; float* out; int ldc; const float* gate; int gstride; float gsc;
    __device__ __forceinline__ void operator()(const f32x4 (&acc)[2][2][4][2], const Unit& u, int wr, int wc, int fr, int fq) const {
        const int row0 = u.pm * BM + wr * 64 + fr; const int col0 = u.pn * BM + wc * 32 + 8 * fq;
        const float* gp = gate + (size_t)(u.pm >> 5) * gstride + col0;
        f32x4 gv[2][2];
#pragma unroll
        for (int bj = 0; bj < 2; ++bj)
#pragma unroll
            for (int n = 0; n < 2; ++n) gv[bj][n] = *(const f32x4*)(gp + bj * HALF + n * 4) * gsc;
#pragma unroll
        for (int ai = 0; ai < 2; ++ai)
#pragma unroll
            for (int m = 0; m < 4; ++m) { const size_t off = (size_t)(row0 + ai * HALF + m * 16) * ldc + col0;
#pragma unroll
                for (int bj = 0; bj < 2; ++bj)
#pragma unroll
                    for (int n = 0; n < 2; ++n) { const f32x4 bs = *(const f32x4*)(base + off + bj * HALF + n * 4); *(f32x4*)(out + off + bj * HALF + n * 4) = bs + gv[bj][n] * acc[ai][bj][m][n]; } }
    }
};
struct EpiInproj {
    static constexpr bool PERM = true, AFTER_DRAIN = false;
    bf16_t* H; bf16_t* QN; bf16_t* KN; const float* qkg; const float* rope; float qscale;
    __device__ __forceinline__ void operator()(const f32x4 (&acc)[2][2][4][2], const Unit& u, int wr, int wc, int fr, int fq) const {
        const int row0 = u.pm * BM + wr * 64 + fr;
        if (u.pn >= 3 || (u.pn == 2 && wc >= 2)) {
            const int cb0 = (u.pn >= 3) ? (u.pn * BM + wc * 32 + 8 * fq) : (512 + 64 * wc + 8 * fq), cstep = (u.pn >= 3) ? HALF : 32;
#pragma unroll
            for (int ai = 0; ai < 2; ++ai)
#pragma unroll
                for (int m = 0; m < 4; ++m) { bf16_t* rowp = H + (size_t)(row0 + ai * HALF + m * 16) * 2304 + cb0;
#pragma unroll
                    for (int bj = 0; bj < 2; ++bj) { const f32x4 v0 = acc[ai][bj][m][0], v1 = acc[ai][bj][m][1];
                        u32x4 w; w.x = cvt_pk_bf16(v0[0], v0[1]); w.y = cvt_pk_bf16(v0[2], v0[3]); w.z = cvt_pk_bf16(v1[0], v1[1]); w.w = cvt_pk_bf16(v1[2], v1[3]);
                        *(u32x4*)(rowp + bj * cstep) = w; } }
        } else {
            const int head = 4 * u.pn + wc; const bool isq = head < 8;
            const float* gs = qkg + (isq ? 0 : 64) + 8 * fq; const float sc = isq ? qscale : 1.0f;
            f32x4 g[2][2];
#pragma unroll
            for (int bj = 0; bj < 2; ++bj)
#pragma unroll
                for (int n = 0; n < 2; ++n) g[bj][n] = *(const f32x4*)(gs + 32 * bj + 4 * n) * sc;
            bf16_t* ob = isq ? (QN + head * 64 + 8 * fq) : (KN + (head - 8) * 64 + 8 * fq); const int opitch = isq ? 512 : 128;
#pragma unroll
            for (int ai = 0; ai < 2; ++ai)
#pragma unroll
                for (int m = 0; m < 4; ++m) { const int row = row0 + ai * HALF + m * 16;
                    float ss = 0.f;
#pragma unroll
                    for (int bj = 0; bj < 2; ++bj)
#pragma unroll
                        for (int n = 0; n < 2; ++n) { const f32x4 v = acc[ai][bj][m][n]; ss += (v[0] * v[0] + v[1] * v[1]) + (v[2] * v[2] + v[3] * v[3]); }
                    ss += __shfl_xor(ss, 16); ss += __shfl_xor(ss, 32);
                    const float rstd = __builtin_amdgcn_rsqf(ss * (1.0f / 64.0f) + 1e-6f);
                    const int t = row & 8191;
#pragma unroll
                    for (int bj = 0; bj < 2; ++bj) { f32x4 y0 = acc[ai][bj][m][0] * rstd * g[bj][0], y1 = acc[ai][bj][m][1] * rstd * g[bj][1];
                        if (rope) { const int pos = bj ? (t & 63) : (t >> 6); const f32x4* cp = (const f32x4*)(rope + (size_t)(pos * 16 + 4 * fq) * 2);
                            const f32x4 c0 = cp[0], c1 = cp[1];
                            y0 = (f32x4){y0[0] * c0[0] - y0[1] * c0[1], y0[0] * c0[1] + y0[1] * c0[0], y0[2] * c0[2] - y0[3] * c0[3], y0[2] * c0[3] + y0[3] * c0[2]};
                            y1 = (f32x4){y1[0] * c1[0] - y1[1] * c1[1], y1[0] * c1[1] + y1[1] * c1[0], y1[2] * c1[2] - y1[3] * c1[3], y1[2] * c1[3] + y1[3] * c1[2]}; }
                        u32x4 w; w.x = cvt_pk_bf16(y0[0], y0[1]); w.y = cvt_pk_bf16(y0[2], y0[3]); w.z = cvt_pk_bf16(y1[0], y1[1]); w.w = cvt_pk_bf16(y1[2], y1[3]);
                        *(u32x4*)(ob + (size_t)row * opitch + 32 * bj) = w; } }
        }
    }
};
struct EpiAny {
    static constexpr bool PERM = true, AFTER_DRAIN = false;
    int kind; EpiInproj eb; EpiSwiglu es; EpiRes er;
    __device__ __forceinline__ void operator()(const f32x4 (&acc)[2][2][4][2], const Unit& u, int wr, int wc, int fr, int fq) const {
        asm volatile("" : "+v"(fr), "+v"(fq));
        if (kind == 0) eb(acc, u, wr, wc, fr, fq); else if (kind == 1) es(acc, u, wr, wc, fr, fq); else er(acc, u, wr, wc, fr, fq);
    }
};

typedef int pg8_i32x4 __attribute__((ext_vector_type(4)));
template <class Epi, class Sched, bool ALIGN_EPI = false, bool SP2 = false, bool I8 = false>
__device__ __forceinline__ void gemm_phase(PG8_LAS unsigned char* lds, const Gemm g, const Sched& S, const Epi& E) {
    int tid_ = threadIdx.x; asm volatile("" : "+v"(tid_));
    const int tid = tid_, wid = __builtin_amdgcn_readfirstlane(tid >> 6), lane = tid & 63, wr = wid >> 2, wc = wid & 3, fr = lane & 15, fq = lane >> 4;
    const int K = g.K, nt = K / BK;
    unsigned voffA[2], voffB[2];
#pragma unroll
    for (int i = 0; i < 2; ++i) { int R, C; stage_rc(tid * 16 + i * 8192, R, C); const int Rb = Epi::PERM ? ((R & ~31) + perm32(R & 31)) : R;
        voffA[i] = (unsigned)(R * K + C) * 2u; voffB[i] = (unsigned)(Rb * K + C) * 2u; }
    const size_t kstep = (size_t)(BK * 2);
    const size_t hstep = (size_t)HALF * K * 2;
    const size_t tstep = 2 * hstep;
    const unsigned ldsw = (unsigned)wid * 1024u;
    const int aoff = lds_byte(wr * 64 + fr, fq * 8), boff = lds_byte(wc * 32 + fr, fq * 8);
#define PG8_SA(b, h) (((b) * 2 + (h)) * HTB)
#define PG8_SB(b, h) ((4 + (b) * 2 + (h)) * HTB)
#define PG8_STAGE(bufoff, gbase, voff) do { _Pragma("unroll") for (int _i = 0; _i < 2; ++_i) \
        __builtin_amdgcn_global_load_lds((const unsigned*)((const char*)(gbase) + (voff)[_i]), (PG8_LAS unsigned*)(lds + (bufoff) + ldsw + _i * 8192), 16, 0, 0); } while (0)
#define PG8_LDA(dst, b, h) do { _Pragma("unroll") for (int m = 0; m < 4; ++m) _Pragma("unroll") for (int k = 0; k < 2; ++k) dst[m][k] = *(const PG8_LAS bf16x8*)(lds + PG8_SA(b, h) + aoff + m * 2048 + k * 1024); } while (0)
#define PG8_LDB(dst, b, h) do { _Pragma("unroll") for (int n = 0; n < 2; ++n) _Pragma("unroll") for (int k = 0; k < 2; ++k) dst[n][k] = *(const PG8_LAS bf16x8*)(lds + PG8_SB(b, h) + boff + n * 2048 + k * 1024); } while (0)
#define PG8_MMA(ai, bj, At, Bt) do { __builtin_amdgcn_s_setprio(1); _Pragma("unroll") for (int m = 0; m < 4; ++m) _Pragma("unroll") for (int n = 0; n < 2; ++n) _Pragma("unroll") for (int k = 0; k < 2; ++k) { \
        if constexpr (I8) acc[ai][bj][m][n] = __builtin_bit_cast(f32x4, __builtin_amdgcn_mfma_i32_16x16x64_i8(__builtin_bit_cast(pg8_i32x4, Bt[n][k]), __builtin_bit_cast(pg8_i32x4, At[m][k]), __builtin_bit_cast(pg8_i32x4, acc[ai][bj][m][n]), 0, 0, 0)); \
        else acc[ai][bj][m][n] = __builtin_amdgcn_mfma_f32_16x16x32_bf16(Bt[n][k], At[m][k], acc[ai][bj][m][n], 0, 0, 0); } __builtin_amdgcn_s_setprio(0); } while (0)
#define PG8_WAIT_V(n) asm volatile("s_waitcnt vmcnt(" #n ")" ::: "memory")
#define PG8_WAIT_L(n) asm volatile("s_waitcnt lgkmcnt(" #n ")" ::: "memory")
#define PG8_BAR __builtin_amdgcn_s_barrier()
#define PG8_SCHED __builtin_amdgcn_sched_barrier(0)
    Unit cur, nxt; int ui = 0;
    if (!S.next(0, cur)) return;
    f32x4 acc[2][2][4][2];
#pragma unroll
    for (int a = 0; a < 2; ++a)
#pragma unroll
        for (int b = 0; b < 2; ++b)
#pragma unroll
            for (int m = 0; m < 4; ++m)
#pragma unroll
                for (int n = 0; n < 2; ++n) acc[a][b][m][n] = (f32x4){0.f, 0.f, 0.f, 0.f};
    bf16x8 At[4][2], B0[2][2], B1[2][2];
    const char* cA = (const char*)g.A + (size_t)cur.pm * tstep; const char* cB = (const char*)g.Bt + (size_t)cur.pn * tstep;
    S.a_ready(cur);
    if constexpr (SP2) {
        PG8_STAGE(PG8_SB(0, 0), cB, voffB); PG8_STAGE(PG8_SB(0, 1), cB + hstep, voffB); PG8_STAGE(PG8_SA(0, 0), cA, voffA); PG8_STAGE(PG8_SA(0, 1), cA + hstep, voffA);
        if (wr == 1) PG8_BAR;
        PG8_WAIT_V(2); PG8_BAR;
        PG8_STAGE(PG8_SB(1, 0), cB + kstep, voffB); PG8_STAGE(PG8_SA(1, 0), cA + kstep, voffA); PG8_STAGE(PG8_SB(1, 1), cB + hstep + kstep, voffB);
        PG8_WAIT_V(6); PG8_BAR;
    } else {
        PG8_STAGE(PG8_SB(0, 0), cB, voffB); PG8_STAGE(PG8_SA(0, 0), cA, voffA); PG8_STAGE(PG8_SB(0, 1), cB + hstep, voffB); PG8_STAGE(PG8_SA(0, 1), cA + hstep, voffA);
        if (wr == 1) PG8_BAR;
        PG8_WAIT_V(4); PG8_BAR;
        PG8_STAGE(PG8_SB(1, 0), cB + kstep, voffB); PG8_STAGE(PG8_SA(1, 0), cA + kstep, voffA); PG8_STAGE(PG8_SB(1, 1), cB + hstep + kstep, voffB);
        PG8_WAIT_V(6); PG8_BAR;
    }
    for (;;) {
        const bool has_next = S.next(ui + 1, nxt);
        const char* nA = has_next ? (const char*)g.A + (size_t)nxt.pm * tstep : cA; const char* nB = has_next ? (const char*)g.Bt + (size_t)nxt.pn * tstep : cB;
        for (int t = 0; t < nt; t += 2) {
            const bool last = (t == nt - 2);
            const char* a1 = cA + (size_t)(t + 1) * kstep;
            const char* a2 = last ? nA : cA + (size_t)(t + 2) * kstep; const char* b2 = last ? nB : cB + (size_t)(t + 2) * kstep;
            const char* a3 = a2 + kstep; const char* b3 = b2 + kstep;
            if (last && has_next) S.a_ready(nxt);
            if constexpr (SP2) {
            PG8_LDB(B0, 0, 0); PG8_LDB(B1, 0, 1); PG8_SCHED; PG8_LDA(At, 0, 0); PG8_STAGE(PG8_SA(1, 1), a1 + hstep, voffA);
            PG8_WAIT_V(8); PG8_WAIT_L(0); PG8_BAR; PG8_MMA(0, 0, At, B0); PG8_MMA(0, 1, At, B1); PG8_BAR; PG8_SCHED;
            PG8_LDA(At, 0, 1); PG8_STAGE(PG8_SB(0, 0), b2, voffB); PG8_STAGE(PG8_SB(0, 1), b2 + hstep, voffB); PG8_STAGE(PG8_SA(0, 0), a2, voffA);
            PG8_WAIT_V(8); PG8_WAIT_L(0); PG8_BAR; PG8_MMA(1, 0, At, B0); PG8_MMA(1, 1, At, B1); PG8_BAR; PG8_SCHED;
            PG8_LDB(B0, 1, 0); PG8_LDB(B1, 1, 1); PG8_SCHED; PG8_LDA(At, 1, 0); PG8_STAGE(PG8_SA(0, 1), a2 + hstep, voffA);
            PG8_WAIT_V(8); PG8_WAIT_L(0); PG8_BAR; PG8_MMA(0, 0, At, B0); PG8_MMA(0, 1, At, B1); PG8_BAR; PG8_SCHED;
            PG8_LDA(At, 1, 1); PG8_STAGE(PG8_SB(1, 0), b3, voffB); PG8_STAGE(PG8_SB(1, 1), b3 + hstep, voffB); PG8_STAGE(PG8_SA(1, 0), a3, voffA);
            PG8_WAIT_V(8); PG8_WAIT_L(0); PG8_BAR; PG8_MMA(1, 0, At, B0); PG8_MMA(1, 1, At, B1); PG8_BAR; PG8_SCHED;
            } else {
            PG8_LDB(B0, 0, 0); PG8_SCHED; PG8_LDA(At, 0, 0); PG8_STAGE(PG8_SA(1, 1), a1 + hstep, voffA);
            PG8_WAIT_L(8); PG8_BAR; PG8_WAIT_L(0); PG8_MMA(0, 0, At, B0); PG8_BAR; PG8_SCHED;
            PG8_LDB(B1, 0, 1); PG8_STAGE(PG8_SB(0, 0), b2, voffB);
            PG8_BAR; PG8_WAIT_L(0); PG8_MMA(0, 1, At, B1); PG8_BAR;
            PG8_LDA(At, 0, 1); PG8_STAGE(PG8_SA(0, 0), a2, voffA);
            PG8_BAR; PG8_WAIT_L(0); PG8_MMA(1, 0, At, B0); PG8_BAR; PG8_SCHED;
            PG8_STAGE(PG8_SB(0, 1), b2 + hstep, voffB);
            PG8_WAIT_V(6); PG8_BAR; PG8_MMA(1, 1, At, B1); PG8_BAR;
            PG8_LDB(B0, 1, 0); PG8_SCHED; PG8_LDA(At, 1, 0); PG8_STAGE(PG8_SA(0, 1), a2 + hstep, voffA);
            PG8_WAIT_L(8); PG8_BAR; PG8_WAIT_L(0); PG8_MMA(0, 0, At, B0); PG8_BAR; PG8_SCHED;
            PG8_LDB(B1, 1, 1); PG8_STAGE(PG8_SB(1, 0), b3, voffB);
            PG8_BAR; PG8_WAIT_L(0); PG8_MMA(0, 1, At, B1); PG8_BAR;
            PG8_LDA(At, 1, 1); PG8_STAGE(PG8_SA(1, 0), a3, voffA);
            PG8_BAR; PG8_WAIT_L(0); PG8_MMA(1, 0, At, B0); PG8_BAR; PG8_SCHED;
            PG8_STAGE(PG8_SB(1, 1), b3 + hstep, voffB);
            PG8_WAIT_V(6); PG8_BAR; PG8_MMA(1, 1, At, B1); PG8_BAR;
            }
        }
        if constexpr (ALIGN_EPI) { if (wr == 0) PG8_BAR; }
        if constexpr (!Epi::AFTER_DRAIN) { E(acc, cur, wr, wc, fr, fq); S.done(cur); }
        if (!has_next) break;
#pragma unroll
        for (int a = 0; a < 2; ++a)
#pragma unroll
            for (int b = 0; b < 2; ++b)
#pragma unroll
                for (int m = 0; m < 4; ++m)
#pragma unroll
                    for (int n = 0; n < 2; ++n) acc[a][b][m][n] = (f32x4){0.f, 0.f, 0.f, 0.f};
        cur = nxt; cA = nA; cB = nB; ++ui;
        if constexpr (ALIGN_EPI) { if (wr == 1) PG8_BAR; }
    }
    PG8_WAIT_V(0);
    if constexpr (!ALIGN_EPI) { if (wr == 0) PG8_BAR; }
    PG8_BAR;
    if constexpr (Epi::AFTER_DRAIN) { E.fused(acc, cur, wr, wc, fr, fq, lds, wid, lane); S.done(cur); }
#undef PG8_SA
#undef PG8_SB
#undef PG8_STAGE
#undef PG8_LDA
#undef PG8_LDB
#undef PG8_MMA
#undef PG8_WAIT_V
#undef PG8_WAIT_L
#undef PG8_BAR
#undef PG8_SCHED
}
}
namespace att {
using bf16_t = unsigned short;
using bf16x8 = __attribute__((ext_vector_type(8))) short;
using s16x4 = __attribute__((ext_vector_type(4))) short;
using f32x16 = __attribute__((ext_vector_type(16))) float;
using u32x4 = __attribute__((ext_vector_type(4))) unsigned;
typedef __attribute__((address_space(3))) const char* lds_cptr;
typedef __attribute__((address_space(3))) char* lds_ptr;
typedef __attribute__((address_space(3))) float LDSF;
typedef __attribute__((address_space(3))) unsigned short LDSH;
constexpr int SEQ = 8192, QP = 512, KP = 128, VP = 2304, OP = 1024;
constexpr int SLOTB = 8192;
constexpr int L_K = 0, L_V = 2 * SLOTB, L_WS = 4 * SLOTB, L_OST = L_WS + 8 * 64 * 4, L_LUT = L_OST + 8 * 4096, L_END = L_LUT + 768 * 4;
constexpr float LOG2E = 1.4426950408889634f;
constexpr float C2 = 0.125f * LOG2E;
__device__ __forceinline__ int crow(int r, int hi) { return (r & 3) + 8 * (r >> 2) + 4 * hi; }
__device__ __forceinline__ void glds16(const void* gsrc, unsigned lds_dst) { unsigned keep;
  asm volatile("s_mov_b32 %0, m0\n\ts_mov_b32 m0, %2\n\ts_nop 0\n\tglobal_load_lds_dwordx4 %1, off\n\ts_mov_b32 m0, %0" : "=&s"(keep) : "v"(gsrc), "s"(lds_dst) : "memory"); }
typedef float f32x2_t __attribute__((ext_vector_type(2))); typedef __bf16 bf16x2_t __attribute__((ext_vector_type(2)));
__device__ __forceinline__ unsigned cvtpk_s(float lo, float hi) { f32x2_t v = {lo, hi}; bf16x2_t b = __builtin_convertvector(v, bf16x2_t); return __builtin_bit_cast(unsigned, b); }
__device__ __forceinline__ unsigned short f2bf1(float f) { return (unsigned short)(cvtpk_s(f, 0.f) & 0xffffu); }
#define ATT_WAIT_BAR(N) asm volatile("s_waitcnt vmcnt(" #N ") lgkmcnt(0)\n\ts_barrier" ::: "memory")
#define ATT_SBAR() __builtin_amdgcn_sched_barrier(0)
__device__ __forceinline__ void qkt(f32x16& p0, f32x16& p1, lds_cptr kb, const bf16x8* qr) {
  const f32x16 z = {};
#pragma unroll
  for (int d0 = 0; d0 < 4; ++d0) {
    const bf16x8 b0 = *(const __attribute__((address_space(3))) bf16x8*)(kb + d0 * 2048);
    const bf16x8 b1 = *(const __attribute__((address_space(3))) bf16x8*)(kb + d0 * 2048 + 512);
    if (d0 == 0) { p0 = __builtin_amdgcn_mfma_f32_32x32x16_bf16(b0, qr[0], z, 0, 0, 0); p1 = __builtin_amdgcn_mfma_f32_32x32x16_bf16(b1, qr[0], z, 0, 0, 0); }
    else { p0 = __builtin_amdgcn_mfma_f32_32x32x16_bf16(b0, qr[d0], p0, 0, 0, 0); p1 = __builtin_amdgcn_mfma_f32_32x32x16_bf16(b1, qr[d0], p1, 0, 0, 0); } }
}
__device__ __forceinline__ void pv(f32x16* o, int vb, bf16x8 pa0, bf16x8 pa1, bf16x8 pa2, bf16x8 pa3) {
#pragma unroll
  for (int d0 = 0; d0 < 2; ++d0) { s16x4 lo[4], hi[4];
#pragma unroll
    for (int ks = 0; ks < 4; ++ks) {
      asm volatile("ds_read_b64_tr_b16 %0,%1 offset:%c2" : "=&v"(lo[ks]) : "v"(vb), "i"(d0 * 4096 + ks * 1024) : "memory");
      asm volatile("ds_read_b64_tr_b16 %0,%1 offset:%c2" : "=&v"(hi[ks]) : "v"(vb), "i"(d0 * 4096 + ks * 1024 + 512) : "memory"); }
    asm volatile("s_waitcnt lgkmcnt(0)" ::: "memory"); ATT_SBAR();
#define ATT_PK(k) (bf16x8){lo[k][0], lo[k][1], lo[k][2], lo[k][3], hi[k][0], hi[k][1], hi[k][2], hi[k][3]}
    o[d0] = __builtin_amdgcn_mfma_f32_32x32x16_bf16(pa0, ATT_PK(0), o[d0], 0, 0, 0);
    o[d0] = __builtin_amdgcn_mfma_f32_32x32x16_bf16(pa1, ATT_PK(1), o[d0], 0, 0, 0);
    o[d0] = __builtin_amdgcn_mfma_f32_32x32x16_bf16(pa2, ATT_PK(2), o[d0], 0, 0, 0);
    o[d0] = __builtin_amdgcn_mfma_f32_32x32x16_bf16(pa3, ATT_PK(3), o[d0], 0, 0, 0);
#undef ATT_PK
  }
}
__device__ __forceinline__ int t5_bucket(int rel) {
  const int n = rel < 0 ? -rel : rel;
  const int large = n < 12 ? 8 : n < 16 ? 9 : n < 23 ? 10 : n < 32 ? 11 : n < 46 ? 12 : n < 64 ? 13 : n < 91 ? 14 : 15;
  return (rel > 0 ? 16 : 0) + (n < 8 ? n : large);
}
__device__ __forceinline__ void attn_unit(const bool WIN, int b, int h, int qb, const bf16_t* Q, const bf16_t* __restrict__ K, const bf16_t* __restrict__ V, bf16_t* O, lds_ptr shm,
                                                               const float* rel_table, float sink2) {
  int tid_ = threadIdx.x; asm volatile("" : "+v"(tid_));
  const int tid = tid_, lane = tid & 63, r32 = lane & 31, hi = lane >> 5; const int wid = __builtin_amdgcn_readfirstlane(tid >> 6);
  const long rowbase = (long)b * SEQ; const int q0 = qb * 256; const int kvh = h >> 2;
  const unsigned lds0 = (unsigned)(uintptr_t)shm;
  LDSF* wsf = (LDSF*)(shm + L_WS) + wid * 64;
  LDSF* lut = (LDSF*)(shm + L_LUT);
  const bf16_t* Kh = K + rowbase * KP + kvh * 64; const bf16_t* Vh = V + rowbase * VP + kvh * 64;
  const bf16_t* ksrc = Kh + (long)lane * KP + wid * 8;
  const bf16_t* vsrc = Vh + (long)(16 * (wid & 3) + (lane >> 2)) * VP + (wid >> 2) * 32 + (lane & 3) * 8;
  const unsigned kdst = lds0 + L_K + wid * 1024, vdst = lds0 + L_V + wid * 1024;
#define ATT_DMA_K(t, slot) glds16(ksrc + (long)(t) * 64 * KP, (unsigned)__builtin_amdgcn_readfirstlane(kdst + (slot)))
#define ATT_DMA_V(t, slot) glds16(vsrc + (long)(t) * 64 * VP, (unsigned)__builtin_amdgcn_readfirstlane(vdst + (slot)))
  const int vb0 = (int)(lds0 + L_V) + ((lane >> 4) & 1) * 32 + (lane & 3) * 8 + (4 * hi + ((lane & 15) >> 2)) * 64;
  const lds_cptr shm3 = (lds_cptr)shm; const lds_cptr kp0 = shm3 + L_K + hi * 1024 + r32 * 16;
  int t_lo = 0, t_hi = SEQ / 64;
  if (WIN) { t_lo = q0 / 64 - 2; if (t_lo < 0) t_lo = 0; t_hi = q0 / 64 + 6; if (t_hi > SEQ / 64) t_hi = SEQ / 64; }
  ATT_DMA_K(t_lo, 0); ATT_DMA_V(t_lo, 0);
  if (WIN) { for (int i = tid; i < 768; i += 512) { const int rel = i - 384; const int n = rel < 0 ? -rel : rel; float v = -INFINITY; if (n <= 128) v = rel_table[t5_bucket(rel) * 8 + h] * LOG2E; lut[i] = v; } }
  const bf16_t* Qw = Q + (rowbase + q0 + wid * 32) * QP + h * 64;
  bf16x8 qr[4];
#pragma unroll
  for (int d0 = 0; d0 < 4; ++d0) qr[d0] = *reinterpret_cast<const bf16x8*>(&Qw[(long)r32 * QP + d0 * 16 + hi * 8]);
  float mhat = WIN ? sink2 : -1.0e30f, l_reg = (WIN && hi == 0) ? 1.f : 0.f; f32x16 o[2]; o[0] = f32x16{}; o[1] = f32x16{};
  const int qw = q0 + wid * 32;
  for (int t = t_lo; t < t_hi; ++t) {
    const int slot = ((t - t_lo) & 1) * SLOTB;
    if (t + 1 < t_hi) { ATT_DMA_K(t + 1, slot ^ SLOTB); ATT_DMA_V(t + 1, slot ^ SLOTB); ATT_WAIT_BAR(2); } else { ATT_WAIT_BAR(0); }
    const int tb = t * 64;
    const bool act = !WIN || !(tb > qw + 31 + 128 || tb + 63 < qw - 128);
    if (act) {
      f32x16 p0, p1; qkt(p0, p1, kp0 + slot, qr);
      if (WIN) { const int base = tb - (qw + r32) + 384 + 4 * hi;
#pragma unroll
        for (int r = 0; r < 16; ++r) { const int ix = base + (r & 3) + 8 * (r >> 2); p0[r] += lut[ix]; p1[r] += lut[ix + 32]; } }
      float m = p0[0];
#pragma unroll
      for (int r = 0; r < 16; ++r) { m = __builtin_fmaxf(m, p0[r]); m = __builtin_fmaxf(m, p1[r]); }
      { auto rr = __builtin_amdgcn_permlane32_swap(__float_as_uint(m), __float_as_uint(m), false, false); m = __builtin_fmaxf(__uint_as_float(rr[0]), __uint_as_float(rr[1])); }
      const float mnew = __builtin_fmaxf(mhat, m); const float f = __builtin_amdgcn_exp2f(mhat - mnew); mhat = mnew; l_reg *= f;
      if (hi == 0) wsf[r32] = f;
      float sacc = 0.f;
#pragma unroll
      for (int r = 0; r < 16; ++r) { p0[r] = __builtin_amdgcn_exp2f(p0[r] - mnew); p1[r] = __builtin_amdgcn_exp2f(p1[r] - mnew); sacc += p0[r] + p1[r]; }
      l_reg += sacc;
      const u32x4 pw0 = {cvtpk_s(p0[0], p0[1]), cvtpk_s(p0[2], p0[3]), cvtpk_s(p0[4], p0[5]), cvtpk_s(p0[6], p0[7])};
      const u32x4 pw1 = {cvtpk_s(p0[8], p0[9]), cvtpk_s(p0[10], p0[11]), cvtpk_s(p0[12], p0[13]), cvtpk_s(p0[14], p0[15])};
      const u32x4 pw2 = {cvtpk_s(p1[0], p1[1]), cvtpk_s(p1[2], p1[3]), cvtpk_s(p1[4], p1[5]), cvtpk_s(p1[6], p1[7])};
      const u32x4 pw3 = {cvtpk_s(p1[8], p1[9]), cvtpk_s(p1[10], p1[11]), cvtpk_s(p1[12], p1[13]), cvtpk_s(p1[14], p1[15])};
      asm volatile("s_waitcnt lgkmcnt(0)" ::: "memory");
#pragma unroll
      for (int r = 0; r < 16; ++r) { const float fr_ = wsf[crow(r, hi)]; o[0][r] *= fr_; o[1][r] *= fr_; }
      ATT_SBAR();
      pv(o, vb0 + slot, __builtin_bit_cast(bf16x8, pw0), __builtin_bit_cast(bf16x8, pw1), __builtin_bit_cast(bf16x8, pw2), __builtin_bit_cast(bf16x8, pw3));
    }
    asm volatile("s_waitcnt lgkmcnt(0)\n\ts_barrier" ::: "memory");
  }
  { auto rr = __builtin_amdgcn_permlane32_swap(__float_as_uint(l_reg), __float_as_uint(l_reg), false, false); l_reg = __uint_as_float(rr[0]) + __uint_as_float(rr[1]); }
  if (hi == 0) wsf[32 + r32] = l_reg; asm volatile("s_waitcnt lgkmcnt(0)" ::: "memory");
  float rli[16];
#pragma unroll
  for (int r = 0; r < 16; ++r) rli[r] = __builtin_amdgcn_rcpf(wsf[32 + crow(r, hi)]);
  bf16_t* Ow = O + (rowbase + q0 + wid * 32) * OP + h * 64;
  { LDSH* stg = (LDSH*)(shm + L_OST) + wid * 2048;
#pragma unroll
    for (int r = 0; r < 16; ++r) { const int orow = crow(r, hi);
#pragma unroll
      for (int d0 = 0; d0 < 2; ++d0) stg[orow * 64 + d0 * 32 + r32] = f2bf1(o[d0][r] * rli[r]); }
    asm volatile("s_waitcnt lgkmcnt(0)" ::: "memory");
#pragma unroll
    for (int i = 0; i < 4; ++i) { const int row = i * 8 + (lane >> 3), ch = lane & 7; const u32x4 v = *(const __attribute__((address_space(3))) u32x4*)(stg + row * 64 + ch * 8); *(u32x4*)(Ow + (long)row * OP + ch * 8) = v; } }
  asm volatile("s_waitcnt vmcnt(0) lgkmcnt(0)\n\ts_barrier" ::: "memory");
#undef ATT_DMA_K
#undef ATT_DMA_V
}
}
namespace attf {
using bf16=__hip_bfloat16;
using bf16x8=__attribute__((ext_vector_type(8)))short;
using s16x4=__attribute__((ext_vector_type(4)))short;
using f32x16=__attribute__((ext_vector_type(16)))float;
using u32x4=__attribute__((ext_vector_type(4)))unsigned;
constexpr int SEQ=8192,D=64,QP=512,KP=128,VP=2304,OP=1024;
constexpr int NW=8,QBLK=32,QB=QBLK*NW,KVBLK=64,NQB=SEQ/QB;
__device__ __forceinline__ int crow(int r,int hi){return (r&3)+8*(r>>2)+4*hi;}
#define SBAR() __builtin_amdgcn_sched_barrier(0)
constexpr int NSLOT=3, SLOTB=8192;
constexpr int LDS_K=0, LDS_V=NSLOT*SLOTB, LDS_WS=2*NSLOT*SLOTB, LDS_OST=LDS_WS+NW*64*4, LDS_BYTES=LDS_OST+NW*4096;
constexpr float C2=0.125f*1.4426950408889634f;
__device__ __forceinline__ void glds16(const void*gsrc,unsigned lds_dst){unsigned keep;
  asm volatile("s_mov_b32 %0, m0\n\ts_mov_b32 m0, %2\n\ts_nop 0\n\tglobal_load_lds_dwordx4 %1, off\n\ts_mov_b32 m0, %0":"=&s"(keep):"v"(gsrc),"s"(lds_dst):"memory");}
__device__ __forceinline__ float max3f(float a,float b,float c){float r;asm("v_max3_f32 %0, %1, %2, %3":"=v"(r):"v"(a),"v"(b),"v"(c));return r;}
__device__ __forceinline__ float max2f(float a,float b){float r;asm("v_max_f32_e32 %0, %1, %2":"=v"(r):"v"(a),"v"(b));return r;}
__device__ __forceinline__ float fadd_s(float a,float b){float r;asm("v_add_f32_e32 %0, %1, %2":"=v"(r):"v"(a),"v"(b));return r;}
__device__ __forceinline__ float fsub_s(float a,float b){float r;asm("v_sub_f32_e32 %0, %1, %2":"=v"(r):"v"(a),"v"(b));return r;}
typedef float f32x2_t __attribute__((ext_vector_type(2))); typedef __bf16 bf16x2_t __attribute__((ext_vector_type(2)));
__device__ __forceinline__ unsigned cvtpk_s(float lo,float hi){f32x2_t v={lo,hi};bf16x2_t b=__builtin_convertvector(v,bf16x2_t);return __builtin_bit_cast(unsigned,b);}
#define WAIT_BAR(N) asm volatile("s_waitcnt vmcnt(" #N ") lgkmcnt(0)\n\ts_barrier":::"memory")

__device__ __forceinline__ void qkt(f32x16&p0,f32x16&p1,const char*Kslot,const bf16x8*qr,const f32x16&negm,int r32,int hi){
  const char*kb=Kslot+hi*1024+r32*16;
  #pragma unroll
  for(int d0=0;d0<4;++d0){
    const bf16x8 b0=*reinterpret_cast<const bf16x8*>(kb+d0*2048);
    const bf16x8 b1=*reinterpret_cast<const bf16x8*>(kb+d0*2048+512);
    if(d0==0){p0=__builtin_amdgcn_mfma_f32_32x32x16_bf16(b0,qr[0],negm,0,0,0);p1=__builtin_amdgcn_mfma_f32_32x32x16_bf16(b1,qr[0],negm,0,0,0);}
    else{p0=__builtin_amdgcn_mfma_f32_32x32x16_bf16(b0,qr[d0],p0,0,0,0);p1=__builtin_amdgcn_mfma_f32_32x32x16_bf16(b1,qr[d0],p1,0,0,0);}}
}
typedef __attribute__((address_space(3))) const char* lds_cptr;
typedef short v4i16_t __attribute__((ext_vector_type(4)));
__device__ __forceinline__ void kload8(bf16x8*kf,lds_cptr kp){
  kf[0]=*(const __attribute__((address_space(3))) bf16x8*)(kp);      kf[1]=*(const __attribute__((address_space(3))) bf16x8*)(kp+512);
  kf[2]=*(const __attribute__((address_space(3))) bf16x8*)(kp+2048); kf[3]=*(const __attribute__((address_space(3))) bf16x8*)(kp+2560);
  kf[4]=*(const __attribute__((address_space(3))) bf16x8*)(kp+4096); kf[5]=*(const __attribute__((address_space(3))) bf16x8*)(kp+4608);
  kf[6]=*(const __attribute__((address_space(3))) bf16x8*)(kp+6144); kf[7]=*(const __attribute__((address_space(3))) bf16x8*)(kp+6656);
}
__device__ __forceinline__ void kload2(bf16x8*kf,lds_cptr kp,int j){ kf[2*j]=*(const __attribute__((address_space(3))) bf16x8*)(kp+j*2048); kf[2*j+1]=*(const __attribute__((address_space(3))) bf16x8*)(kp+j*2048+512); }
__device__ __forceinline__ s16x4 vtr(lds_cptr p){ return __builtin_bit_cast(s16x4,__builtin_amdgcn_ds_read_tr16_b64_v4i16((__attribute__((address_space(3))) v4i16_t*)p)); }
__device__ __forceinline__ float rowmax(const f32x16&p0,const f32x16&p1){
  float a=max3f(p0[0],p0[1],p1[0]),b=max3f(p0[2],p0[3],p1[1]);a=max3f(a,p1[2],p1[3]);
  #pragma unroll
  for(int r=4;r<16;r+=4){a=max3f(a,p0[r],p0[r+1]);b=max3f(b,p0[r+2],p0[r+3]);a=max3f(a,p1[r],p1[r+1]);b=max3f(b,p1[r+2],p1[r+3]);}
  const float m=max2f(a,b);
  auto rr=__builtin_amdgcn_permlane32_swap(__float_as_uint(m),__float_as_uint(m),false,false);
  return max2f(__uint_as_float(rr[0]),__uint_as_float(rr[1]));
}
__device__ __forceinline__ void pv(f32x16*o,int vb,bf16x8 pa0,bf16x8 pa1,bf16x8 pa2,bf16x8 pa3){
  #pragma unroll
  for(int d0=0;d0<2;++d0){s16x4 lo[4],hi[4];
    #pragma unroll
    for(int ks=0;ks<4;++ks){
      asm volatile("ds_read_b64_tr_b16 %0,%1 offset:%c2":"=&v"(lo[ks]):"v"(vb),"i"(d0*4096+ks*1024):"memory");
      asm volatile("ds_read_b64_tr_b16 %0,%1 offset:%c2":"=&v"(hi[ks]):"v"(vb),"i"(d0*4096+ks*1024+512):"memory");}
    asm volatile("s_waitcnt lgkmcnt(0)":::"memory");SBAR();
    #define PK(k) (bf16x8){lo[k][0],lo[k][1],lo[k][2],lo[k][3],hi[k][0],hi[k][1],hi[k][2],hi[k][3]}
    o[d0]=__builtin_amdgcn_mfma_f32_32x32x16_bf16(pa0,PK(0),o[d0],0,0,0);
    o[d0]=__builtin_amdgcn_mfma_f32_32x32x16_bf16(pa1,PK(1),o[d0],0,0,0);
    o[d0]=__builtin_amdgcn_mfma_f32_32x32x16_bf16(pa2,PK(2),o[d0],0,0,0);
    o[d0]=__builtin_amdgcn_mfma_f32_32x32x16_bf16(pa3,PK(3),o[d0],0,0,0);
    #undef PK
  }
}

#ifndef ATTN_STORE16
#define ATTN_STORE16(p,v) (*(u32x4*)(p)=(v))
#endif
template<int THRL> __device__ __forceinline__ void attn_unit(int b,int h,int qb,const bf16*Q,const bf16*__restrict__ K,const bf16*__restrict__ V,bf16*O,char*shm){
  int tid_=threadIdx.x; asm volatile("":"+v"(tid_)); const int tid=tid_,lane=tid&63,r32=lane&31,hi=lane>>5; const int wid=__builtin_amdgcn_readfirstlane(tid>>6); const int kvh=h>>2;
  const long rowbase=(long)b*SEQ; const int q0=qb*QB;
  const bf16*Qw=Q+(rowbase+q0+wid*QBLK)*QP+h*D;
  const bf16*Kh=K+rowbase*KP+kvh*D,*Vh=V+rowbase*VP+kvh*D;
  const unsigned lds0=(unsigned)(uintptr_t)shm;
  float*wsf=(float*)(shm+LDS_WS)+wid*64;
  const bf16*ksrc=Kh+(long)lane*KP+wid*8;
  const bf16*vsrc=Vh+(long)(16*(wid&3)+(lane>>2))*VP+(wid>>2)*32+(lane&3)*8;
  const unsigned kdst=lds0+LDS_K+wid*1024, vdst=lds0+LDS_V+wid*1024;
  #define DMA_K(t,slot) glds16(ksrc+(long)(t)*KVBLK*KP,(unsigned)__builtin_amdgcn_readfirstlane(kdst+(slot)))
  #define DMA_V(t,slot) glds16(vsrc+(long)(t)*KVBLK*VP,(unsigned)__builtin_amdgcn_readfirstlane(vdst+(slot)))
  const int vb0=(int)(lds0+LDS_V)+((lane>>4)&1)*32+(lane&3)*8+(4*hi+((lane&15)>>2))*64;
  const char*Kbase=shm+LDS_K; bf16x8 kf[8];
  const lds_cptr shm3=(lds_cptr)shm; const lds_cptr kp0=shm3+LDS_K+hi*1024+r32*16; const lds_cptr vp0=shm3+LDS_V+((lane>>4)&1)*32+(lane&3)*8+(4*hi+((lane&15)>>2))*64;
  const int NT=SEQ/KVBLK;
  DMA_K(0,0);DMA_V(0,0);DMA_K(1,SLOTB);
  bf16x8 qr[4];
  #pragma unroll
  for(int d0=0;d0<4;++d0)qr[d0]=*reinterpret_cast<const bf16x8*>(&Qw[(long)r32*QP+d0*16+hi*8]);
  float mhat=0.f,l_reg=0.f;f32x16 o[2];o[0]=f32x16{};o[1]=f32x16{};f32x16 negm=f32x16{};asm volatile("":"+v"(negm));
    #define CMASK(P0,P1,t) do{}while(0)
  bool resc=false;
  #define START(P0,P1) do{ const float rm=rowmax(P0,P1); resc=false; \
    { const float dl=rm; mhat=fadd_s(mhat,dl); \
      _Pragma("unroll") for(int r=0;r<16;++r){P0[r]=fsub_s(P0[r],dl);P1[r]=fsub_s(P1[r],dl);} \
      _Pragma("unroll") for(int r=0;r<16;++r)negm[r]=-mhat; asm volatile("":"+v"(negm)); } \
    _Pragma("unroll") for(int r=0;r<16;++r)P0[r]=__builtin_amdgcn_exp2f(P0[r]); }while(0)
  #define RESC() do{ if(resc){ asm volatile("s_waitcnt lgkmcnt(0)":::"memory"); \
      _Pragma("unroll") for(int d_=0;d_<2;++d_) _Pragma("unroll") for(int r=0;r<16;++r)o[d_][r]*=wsf[crow(r,hi)]; } }while(0)
  f32x16 pA0,pA1,pB0,pB1;
  int sl_prev=0,sl_cur=0,sl_next=SLOTB;
  #define ROT() do{sl_prev=sl_cur;sl_cur=sl_next;sl_next=(sl_next==(NSLOT-1)*SLOTB)?0:sl_next+SLOTB;}while(0)
  DMA_K(2,2*SLOTB);
  WAIT_BAR(3);
  qkt(pA0,pA1,Kbase,qr,negm,r32,hi);asm volatile("s_nop 15\n\ts_nop 7":"+v"(pA0),"+v"(pA1));CMASK(pA0,pA1,0);
  START(pA0,pA1);
  _Pragma("unroll") for(int r=0;r<16;++r)pA1[r]=__builtin_amdgcn_exp2f(pA1[r]);
  WAIT_BAR(0);
  DMA_K(3,0);DMA_V(1,SLOTB);
  ROT();
  kload8(kf,kp0+sl_cur);
  WAIT_BAR(2);
  s16x4 vlo[8],vhi[8]; u32x4 pw0,pw1,pw2,pw3;
  #define PKW(P,B) cvtpk_s(P[B],P[B+1])
  #define PAF(k) __builtin_bit_cast(bf16x8,pw##k)
  #define VFR(i) (bf16x8){vlo[i][0],vlo[i][1],vlo[i][2],vlo[i][3],vhi[i][0],vhi[i][1],vhi[i][2],vhi[i][3]}
  #define PIN(x) asm volatile("":"+v"(x))
  #define MX3(a,b,c) __builtin_fmaxf(__builtin_fmaxf((a),(b)),(c))
  #define GAPA(MF,A0,A1,A2,A3,W0,W1,PW) do{ MF; sacc+=A0; sacc+=A1; sacc+=A2; sacc+=A3; PIN(sacc); W0; W1; PIN(PW); SBAR(); }while(0)
  #define EX(v) __builtin_amdgcn_exp2f(v)
  #define GAPB(MF,X,B) do{ MF; X[B]=EX(X[B]); X[B+1]=EX(X[B+1]); X[B+2]=EX(X[B+2]); X[B+3]=EX(X[B+3]); PIN(X); SBAR(); }while(0)
  #define VRD(i) do{ vlo[i]=vtr(vp_+(((i)>>2)*4096+((i)&3)*1024)); vhi[i]=vtr(vp_+(((i)>>2)*4096+((i)&3)*1024+512)); }while(0)
  #define KRD(G,j) do{ if(G){ kload2(kf,kp0+sl_next,j); SBAR(); } }while(0)
  #define STEP(C0,C1,P0,P1,t,GK,GV,GL) do{ SBAR(); \
    const lds_cptr vp_=vp0+sl_prev; \
    VRD(0); SBAR(); float sacc=(P0[0]+P0[1]); \
    GAPA(C0=__builtin_amdgcn_mfma_f32_32x32x16_bf16(kf[0],qr[0],negm,0,0,0), P0[2],P0[3],P0[4],P0[5],     pw0[0]=PKW(P0,0), pw0[1]=PKW(P0,2), pw0); \
    VRD(4); SBAR(); GAPA(C1=__builtin_amdgcn_mfma_f32_32x32x16_bf16(kf[1],qr[0],negm,0,0,0), P0[6],P0[7],P0[8],P0[9],     pw0[2]=PKW(P0,4), pw0[3]=PKW(P0,6), pw0); \
    VRD(1); SBAR(); GAPA(C0=__builtin_amdgcn_mfma_f32_32x32x16_bf16(kf[2],qr[1],C0,0,0,0),   P0[10],P0[11],P0[12],P0[13], pw1[0]=PKW(P0,8), pw1[1]=PKW(P0,10), pw1); \
    VRD(5); SBAR(); GAPA(C1=__builtin_amdgcn_mfma_f32_32x32x16_bf16(kf[3],qr[1],C1,0,0,0),   P0[14],P0[15],P1[0],P1[1],   pw1[2]=PKW(P0,12),pw1[3]=PKW(P0,14), pw1); \
    VRD(2); SBAR(); GAPA(C0=__builtin_amdgcn_mfma_f32_32x32x16_bf16(kf[4],qr[2],C0,0,0,0),   P1[2],P1[3],P1[4],P1[5],     pw2[0]=PKW(P1,0), pw2[1]=PKW(P1,2), pw2); \
    VRD(6); SBAR(); GAPA(C1=__builtin_amdgcn_mfma_f32_32x32x16_bf16(kf[5],qr[2],C1,0,0,0),   P1[6],P1[7],P1[8],P1[9],     pw2[2]=PKW(P1,4), pw2[3]=PKW(P1,6), pw2); \
    VRD(3); SBAR(); GAPA(C0=__builtin_amdgcn_mfma_f32_32x32x16_bf16(kf[6],qr[3],C0,0,0,0),   P1[10],P1[11],P1[12],P1[13], pw3[0]=PKW(P1,8), pw3[1]=PKW(P1,10), pw3); \
    VRD(7); SBAR(); GAPA(C1=__builtin_amdgcn_mfma_f32_32x32x16_bf16(kf[7],qr[3],C1,0,0,0),   P1[14],P1[15],0.f,0.f,       pw3[2]=PKW(P1,12),pw3[3]=PKW(P1,14), pw3); \
    l_reg+=sacc; \
    if(GK){DMA_K((t)+3,sl_cur);} if(GV){DMA_V((t)+1,sl_next);} \
    CMASK(C0,C1,t); \
    { float a=MX3(C0[0],C0[1],C1[0]),b=MX3(C0[2],C0[3],C1[1]); a=MX3(a,C1[2],C1[3]); \
      _Pragma("unroll") for(int r=4;r<16;r+=4){a=MX3(a,C0[r],C0[r+1]);b=MX3(b,C0[r+2],C0[r+3]);a=MX3(a,C1[r],C1[r+1]);b=MX3(b,C1[r+2],C1[r+3]);} \
      float rm=__builtin_fmaxf(a,b); { auto rr=__builtin_amdgcn_permlane32_swap(__float_as_uint(rm),__float_as_uint(rm),false,false); rm=__builtin_fmaxf(__uint_as_float(rr[0]),__uint_as_float(rr[1])); } \
      resc=false; \
      if(__builtin_expect(__any(rm>(float)THRL),0)){ const float dl=__builtin_fmaxf(rm,0.f); mhat+=dl; \
        _Pragma("unroll") for(int r=0;r<16;++r){C0[r]-=dl;C1[r]-=dl;} \
        _Pragma("unroll") for(int r=0;r<16;++r)negm[r]=-mhat; asm volatile("":"+v"(negm)); \
        const float f=__builtin_amdgcn_exp2f(-dl); l_reg*=f; if(hi==0)wsf[r32]=f; resc=true; } } \
    SBAR(); \
    GAPB(o[0]=__builtin_amdgcn_mfma_f32_32x32x16_bf16(PAF(0),VFR(0),o[0],0,0,0), C0,0); \
    GAPB(o[1]=__builtin_amdgcn_mfma_f32_32x32x16_bf16(PAF(0),VFR(4),o[1],0,0,0), C0,4); \
    KRD(GL,0); GAPB(o[0]=__builtin_amdgcn_mfma_f32_32x32x16_bf16(PAF(1),VFR(1),o[0],0,0,0), C0,8); \
    KRD(GL,1); GAPB(o[1]=__builtin_amdgcn_mfma_f32_32x32x16_bf16(PAF(1),VFR(5),o[1],0,0,0), C0,12); \
    KRD(GL,2); GAPB(o[0]=__builtin_amdgcn_mfma_f32_32x32x16_bf16(PAF(2),VFR(2),o[0],0,0,0), C1,0); \
    KRD(GL,3); GAPB(o[1]=__builtin_amdgcn_mfma_f32_32x32x16_bf16(PAF(2),VFR(6),o[1],0,0,0), C1,4); \
    GAPB(o[0]=__builtin_amdgcn_mfma_f32_32x32x16_bf16(PAF(3),VFR(3),o[0],0,0,0), C1,8); \
    GAPB(o[1]=__builtin_amdgcn_mfma_f32_32x32x16_bf16(PAF(3),VFR(7),o[1],0,0,0), C1,12); \
    }while(0)
  int t=1;
  for(;t+5<NT;t+=2){
    STEP(pB0,pB1,pA0,pA1,t,true,true,true);     WAIT_BAR(2); RESC(); ROT();
    STEP(pA0,pA1,pB0,pB1,t+1,true,true,true);   WAIT_BAR(2); RESC(); ROT();
  }
  #define ENDW(tt) do{ if((tt)+3<NT){WAIT_BAR(2);} else if((tt)+2<NT){WAIT_BAR(1);} else {WAIT_BAR(0);} }while(0)
  for(;t+1<NT;t+=2){
    STEP(pB0,pB1,pA0,pA1,t,(t+3<NT),(t+1<NT),(t+1<NT));       ENDW(t);   RESC(); ROT();
    STEP(pA0,pA1,pB0,pB1,t+1,(t+4<NT),(t+2<NT),(t+2<NT));     ENDW(t+1); RESC(); ROT();
  }
  STEP(pB0,pB1,pA0,pA1,NT-1,false,false,false); RESC();
  { float sacc=pB0[0]+pB0[1]; _Pragma("unroll") for(int r=2;r<16;++r)sacc+=pB0[r]; _Pragma("unroll") for(int r=0;r<16;++r)sacc+=pB1[r]; l_reg+=sacc;
    pw0=(u32x4){PKW(pB0,0),PKW(pB0,2),PKW(pB0,4),PKW(pB0,6)};pw1=(u32x4){PKW(pB0,8),PKW(pB0,10),PKW(pB0,12),PKW(pB0,14)};pw2=(u32x4){PKW(pB1,0),PKW(pB1,2),PKW(pB1,4),PKW(pB1,6)};pw3=(u32x4){PKW(pB1,8),PKW(pB1,10),PKW(pB1,12),PKW(pB1,14)};
    SBAR(); pv(o,vb0+sl_cur,PAF(0),PAF(1),PAF(2),PAF(3)); }
  #undef PKW
  #undef PAF
  #undef VFR
  #undef PIN
  #undef MX3
  #undef GAPA
  #undef GAPB
  #undef EX
  #undef VRD
  #undef KRD
  #undef STEP
  #undef ENDW
  {auto rr=__builtin_amdgcn_permlane32_swap(__float_as_uint(l_reg),__float_as_uint(l_reg),false,false);l_reg=__uint_as_float(rr[0])+__uint_as_float(rr[1]);}
  if(hi==0)wsf[32+r32]=l_reg;asm volatile("s_waitcnt lgkmcnt(0)":::"memory");
  float rli[16];
  #pragma unroll
  for(int r=0;r<16;++r)rli[r]=__builtin_amdgcn_rcpf(wsf[32+crow(r,hi)]);
  bf16*Ow=O+(rowbase+q0+wid*QBLK)*OP+h*D;
  { bf16*stg=(bf16*)(shm+LDS_OST)+wid*2048;
    #pragma unroll
    for(int r=0;r<16;++r){const int orow=crow(r,hi);
      #pragma unroll
      for(int d0=0;d0<2;++d0)stg[orow*64+d0*32+r32]=__float2bfloat16(o[d0][r]*rli[r]);}
    asm volatile("s_waitcnt lgkmcnt(0)":::"memory");
    #pragma unroll
    for(int i=0;i<4;++i){const int row=i*8+(lane>>3),ch=lane&7; const u32x4 v=*(const u32x4*)(stg+row*64+ch*8); ATTN_STORE16(Ow+(long)row*OP+ch*8,v);} }
  asm volatile("s_waitcnt lgkmcnt(0)\n\ts_barrier":::"memory");
  #undef DMA_K
  #undef DMA_V
  #undef CMASK
  #undef START
  #undef RESC
  #undef ROT
}
constexpr int ATTN_LDS_BYTES=LDS_BYTES;
#undef SBAR
#undef WAIT_BAR
}
#define GAS __attribute__((address_space(1)))
#define LAS __attribute__((address_space(3)))
typedef unsigned short bf16;
typedef unsigned v4u __attribute__((ext_vector_type(4)));
typedef unsigned v2u __attribute__((ext_vector_type(2)));
typedef float f32x4 __attribute__((ext_vector_type(4)));
typedef float f32x2 __attribute__((ext_vector_type(2)));
#ifndef FFN_I8
#define FFN_I8 1
#endif
constexpr int NWAVES = 8, NTHR = 512;
constexpr int BATCH = 2, SEQ = 8192, DMODEL = 1024, MTOK = BATCH * SEQ, DFF = 2752, DFFP = 2816, N13 = 5632, INCOLS = 2304, MODC = 9216;
constexpr float EPS = 1e-6f;
constexpr size_t MiB = 1u << 20;
constexpr size_t WS_CTL = 0, CTL_ZERO_BYTES = 1 * MiB;
constexpr size_t WS_MVEC = 512 * 1024;
constexpr size_t WS_ROPE = 1 * MiB;
constexpr size_t WS_CMAX = 768 * 1024;
constexpr size_t WS_SW = 1 * MiB + 64 * 1024;
constexpr size_t WS_SA = 1 * MiB + 128 * 1024;
constexpr size_t WS_H3 = 2 * MiB;
constexpr size_t WS_W13 = 4 * MiB, W13_STRIDE = 11 * MiB;
constexpr size_t WS_W2T = 26 * MiB, W2T_STRIDE = 11 * MiB / 2;
constexpr size_t WS_WIN = 37 * MiB;
constexpr size_t WS_WOUT = WS_WIN + 9 * MiB / 2;
constexpr size_t WS_XN = 44 * MiB;
constexpr size_t WS_HID = 76 * MiB;
constexpr size_t WS_QN = 148 * MiB;
constexpr size_t WS_KN = 164 * MiB;
constexpr size_t WS_ZT = 168 * MiB;
constexpr size_t WS_KF = 200 * MiB;
constexpr size_t WS_END = 264 * MiB;
static_assert(WS_WOUT + 2 * MiB <= WS_XN && WS_HID + (size_t)MTOK * DFFP * 2 == WS_KN && WS_HID + (size_t)MTOK * INCOLS * 2 == WS_QN, "ws map");
constexpr int CW_BAR = 4096;
constexpr int LDS_BYTES = 147456;
constexpr int SCR_BYTES = 139264;
constexpr int MISC_OFF = 143360;
#define LDS_WAIT() asm volatile("s_waitcnt lgkmcnt(0)" ::: "memory")
#define VM_WAIT() asm volatile("s_waitcnt vmcnt(0)" ::: "memory")
__device__ __forceinline__ float bf_lo(unsigned v) { return __uint_as_float(v << 16); }
__device__ __forceinline__ float bf_hi(unsigned v) { return __uint_as_float(v & 0xffff0000u); }
__device__ __forceinline__ float bf1(unsigned short v) { return __uint_as_float((unsigned)v << 16); }
__device__ __forceinline__ unsigned pk2(float lo, float hi) { return att::cvtpk_s(lo, hi); }
__device__ __forceinline__ float wave_sum(float v) {
#pragma unroll
    for (int o = 1; o < 64; o <<= 1) v += __shfl_xor(v, o);
    return v;
}
template <class T> __device__ __forceinline__ T* uni_ptr(T* p) { const unsigned long long v = (unsigned long long)p; const unsigned lo = __builtin_amdgcn_readfirstlane((unsigned)v), hi = __builtin_amdgcn_readfirstlane((unsigned)(v >> 32)); return (T*)(((unsigned long long)hi << 32) | lo); }
__device__ __forceinline__ int uni_i(int v) { return __builtin_amdgcn_readfirstlane(v); }
#define XB_TMO      128
#define XB_XCNT(j)  (256  + 64 * (j))
#define XB_XSUB(j)  (1280 + 64 * (j))
#define XB_XGEN(j)  (2304 + 64 * (j))
#define XB_TOP      3328
#define XB_TOPGEN   3392
#define XCD_BAR_WORDS 3456
#define XB_SPIN_CAP (1u << 18)

__device__ __forceinline__ unsigned xb_ld(unsigned* p)              { return __hip_atomic_load(p, __ATOMIC_RELAXED, __HIP_MEMORY_SCOPE_AGENT); }
__device__ __forceinline__ unsigned xb_add(unsigned* p, unsigned v) { return __hip_atomic_fetch_add(p, v, __ATOMIC_RELAXED, __HIP_MEMORY_SCOPE_AGENT); }
__device__ __forceinline__ unsigned xb_xcc_id() { return (unsigned)__builtin_amdgcn_s_getreg((3 << 11) | 20) & 0xFu; }
#define XB_SPIN(cond, bar) do { unsigned _sp = 0; while (cond) { __builtin_amdgcn_s_sleep(1); \
    if ((++_sp & 255u) == 0u) { if (xb_ld(&(bar)[XB_TMO])) break; if (_sp > XB_SPIN_CAP) { atomicAdd(&(bar)[XB_TMO], 1u); break; } } } } while (0)

struct XcdBarrier {
    unsigned* bar; unsigned x;
    volatile LAS unsigned* st;
};

__device__ __forceinline__ XcdBarrier xcd_barrier_post(unsigned* bar, volatile LAS unsigned* st) {
    XcdBarrier b; b.bar = bar; b.x = xb_xcc_id(); b.st = st;
    if (threadIdx.x == 0) (void)xb_add(&bar[XB_XCNT(b.x)], 1u);
    return b;
}
__device__ __forceinline__ void xcd_barrier_complete(unsigned* bar, unsigned x, unsigned& nloc, unsigned& nx) {
    const unsigned G = gridDim.x * gridDim.y * gridDim.z;
    unsigned sum, cnt, mine, sp = 0u;
    for (;;) {
        sum = 0u; cnt = 0u; mine = 0u;
#pragma unroll
        for (unsigned j = 0; j < 16; ++j) { const unsigned c = xb_ld(&bar[XB_XCNT(j)]); sum += c; cnt += (c > 0u) ? 1u : 0u; mine = (j == x) ? c : mine; }
        if (sum == G) break;
        __builtin_amdgcn_s_sleep(1);
        if ((++sp & 255u) == 0u) { if (xb_ld(&bar[XB_TMO])) break; if (sp > XB_SPIN_CAP) { atomicAdd(&bar[XB_TMO], 1u); break; } }
    }
    nloc = mine > 0u ? mine : 1u; nx = cnt > 0u ? cnt : 1u;
}

__device__ __forceinline__ void xcd_barrier(const XcdBarrier& b) {
    asm volatile("s_waitcnt vmcnt(0)" ::: "memory");
    __syncthreads();
    if (threadIdx.x == 0) {
        unsigned* bar = b.bar;
        __builtin_amdgcn_s_waitcnt(0);
        unsigned nloc = b.st[0], nx = b.st[1];
        if (nloc == 0u) { xcd_barrier_complete(bar, b.x, nloc, nx); b.st[0] = nloc; b.st[1] = nx; }
        const unsigned old = xb_add(&bar[XB_XSUB(b.x)], 1u);
        const unsigned gen = old / nloc;
        if (old + 1u == (gen + 1u) * nloc) {
            __builtin_amdgcn_fence(__ATOMIC_RELEASE, "agent");
            asm volatile("s_waitcnt vmcnt(0)" ::: "memory");
            const unsigned og = xb_add(&bar[XB_TOP], 1u);
            const unsigned tg = og / nx;
            if (og + 1u == (tg + 1u) * nx) xb_add(&bar[XB_TOPGEN], 1u);
            else XB_SPIN(xb_ld(&bar[XB_TOPGEN]) == tg, bar);
            __builtin_amdgcn_fence(__ATOMIC_ACQUIRE, "agent");
            xb_add(&bar[XB_XGEN(b.x)], 1u);
            asm volatile("s_waitcnt vmcnt(0)" ::: "memory");
        } else {
            XB_SPIN(xb_ld(&bar[XB_XGEN(b.x)]) == gen, bar);
            __builtin_amdgcn_fence(__ATOMIC_ACQUIRE, "agent");
            asm volatile("s_waitcnt vmcnt(0)" ::: "memory");
        }
    }
    __syncthreads();
}
struct Args { const float* in[27]; float* out; unsigned char* ws; int ph_lo, ph_hi, use_cg, pad; };
struct Ctx {
    LAS unsigned char* lds; int tid, lane, wave, vcu, G;
    float* out; unsigned char* ws;
};
__device__ __forceinline__ void transpose_item(const float* W, int N, int k0, int n0src, bool valid, bf16* WT, size_t drow0, int Kd, LAS float* scr, int lane) {
    if (valid) {
#pragma unroll 8
        for (int i = 0; i < 32; ++i) { const int kk = 2 * i + (lane >> 5); scr[kk * 33 + (lane & 31)] = W[(size_t)(k0 + kk) * N + n0src + (lane & 31)]; }
    } else {
#pragma unroll 8
        for (int i = 0; i < 32; ++i) { const int kk = 2 * i + (lane >> 5); scr[kk * 33 + (lane & 31)] = 0.f; }
    }
    LDS_WAIT(); asm volatile("" ::: "memory");
    const int c = lane & 7;
#pragma unroll
    for (int j = 0; j < 4; ++j) { const int n = (lane >> 3) + 8 * j; const LAS float* s = scr + (8 * c) * 33 + n;
        v4u o; o.x = pk2(s[0 * 33], s[1 * 33]); o.y = pk2(s[2 * 33], s[3 * 33]); o.z = pk2(s[4 * 33], s[5 * 33]); o.w = pk2(s[6 * 33], s[7 * 33]);
        *(v4u*)(WT + (drow0 + n) * (size_t)Kd + k0 + 8 * c) = o; }
    LDS_WAIT(); asm volatile("" ::: "memory");
}
__device__ __forceinline__ unsigned pack4_i8(float a, float b, float c, float d) {
    const int ia = (int)__builtin_rintf(__builtin_fminf(__builtin_fmaxf(a, -127.f), 127.f)), ib = (int)__builtin_rintf(__builtin_fminf(__builtin_fmaxf(b, -127.f), 127.f));
    const int ic = (int)__builtin_rintf(__builtin_fminf(__builtin_fmaxf(c, -127.f), 127.f)), id = (int)__builtin_rintf(__builtin_fminf(__builtin_fmaxf(d, -127.f), 127.f));
    return (unsigned)(ia & 255) | ((unsigned)(ib & 255) << 8) | ((unsigned)(ic & 255) << 16) | ((unsigned)(id & 255) << 24); }
__device__ __forceinline__ void w13_colmax(const Ctx& F, const Args& A) {
    const int gw = F.vcu * NWAVES + F.wave, NGW = F.G * NWAVES; unsigned* cm = (unsigned*)(F.ws + WS_CMAX);
    for (int it = gw; it < 8 * 11 * 8; it += NGW) {
        const int mi = it / 88, rem = it % 88, nc = rem >> 3, kc = rem & 7; const int n0 = nc * 256 + 4 * F.lane;
        if (n0 >= DFF) continue;
        const float* wp = ((mi & 1) ? A.in[9] : A.in[8]) + (size_t)(mi >> 1) * DMODEL * DFF + (size_t)(kc * 128) * DFF + n0;
        f32x4 mx = {0.f, 0.f, 0.f, 0.f};
#pragma unroll 8
        for (int k = 0; k < 128; ++k) { const f32x4 w = *(const f32x4*)(wp + (size_t)k * DFF); mx.x = __builtin_fmaxf(mx.x, __builtin_fabsf(w.x)); mx.y = __builtin_fmaxf(mx.y, __builtin_fabsf(w.y)); mx.z = __builtin_fmaxf(mx.z, __builtin_fabsf(w.z)); mx.w = __builtin_fmaxf(mx.w, __builtin_fabsf(w.w)); }
        unsigned* d = cm + (size_t)mi * DFF + n0;
        atomicMax(d, __float_as_uint(mx.x)); atomicMax(d + 1, __float_as_uint(mx.y)); atomicMax(d + 2, __float_as_uint(mx.z)); atomicMax(d + 3, __float_as_uint(mx.w));
    }
}
__device__ __forceinline__ void transpose_item_i8(const float* W, int N, int k0, int n0src, bool valid, unsigned char* WT, size_t drow0, int Kd, const unsigned* cmax, float* sW, LAS float* scr, int lane) {
    if (valid) {
#pragma unroll 8
        for (int i = 0; i < 32; ++i) { const int kk = 2 * i + (lane >> 5); scr[kk * 33 + (lane & 31)] = W[(size_t)(k0 + kk) * N + n0src + (lane & 31)]; }
    } else {
#pragma unroll 8
        for (int i = 0; i < 32; ++i) { const int kk = 2 * i + (lane >> 5); scr[kk * 33 + (lane & 31)] = 0.f; }
    }
    LDS_WAIT(); asm volatile("" ::: "memory");
    const int c = lane & 7;
#pragma unroll
    for (int j = 0; j < 4; ++j) { const int n = (lane >> 3) + 8 * j; const LAS float* s = scr + (8 * c) * 33 + n;
        float cm = valid ? __uint_as_float(cmax[n0src + n]) : 0.f; const float inv = cm > 0.f ? 127.0f / cm : 0.f;
        if (k0 == 0 && c == 0) sW[drow0 + n] = cm > 0.f ? cm * (1.0f / 127.0f) : 1.0f;
        if (FFN_I8 == 2) { v4u o; o.x = pk2(__builtin_rintf(inv * s[0 * 33]), __builtin_rintf(inv * s[1 * 33])); o.y = pk2(__builtin_rintf(inv * s[2 * 33]), __builtin_rintf(inv * s[3 * 33])); o.z = pk2(__builtin_rintf(inv * s[4 * 33]), __builtin_rintf(inv * s[5 * 33])); o.w = pk2(__builtin_rintf(inv * s[6 * 33]), __builtin_rintf(inv * s[7 * 33]));
            *(v4u*)((bf16*)WT + (drow0 + n) * (size_t)Kd + k0 + 8 * c) = o; }
        else { v2u o; o.x = pack4_i8(inv * s[0 * 33], inv * s[1 * 33], inv * s[2 * 33], inv * s[3 * 33]); o.y = pack4_i8(inv * s[4 * 33], inv * s[5 * 33], inv * s[6 * 33], inv * s[7 * 33]);
        *(v2u*)(WT + (drow0 + n) * (size_t)Kd + k0 + 8 * c) = o; } }
    LDS_WAIT(); asm volatile("" ::: "memory");
}
__device__ __forceinline__ void convert_weights(const Ctx& F, const Args& A, int l, int parts) {
    LAS float* scr = (LAS float*)(F.lds + F.wave * 16384);
    const int gw = F.vcu * NWAVES + F.wave, NGW = F.G * NWAVES;
    constexpr int I13 = 16 * 176, I2 = 44 * 32, IIN = 16 * 72, IOUT = 16 * 32, NIT = 2 * I13 + 2 * I2 + IIN + IOUT;
    for (int it = gw; it < NIT; it += NGW) {
        int r = it;
        if (r < 2 * I13) { const int f = r / I13; r -= f * I13; if (!((parts >> f) & 1)) continue; const int kb = r / 176, nb = r % 176, np = 32 * nb, pn = np >> 8, bj = (np >> 7) & 1, j0 = np & 127, sc = 128 * pn + j0;
            const float* src = (bj ? A.in[9] : A.in[8]) + (size_t)(l * 2 + f) * DMODEL * DFF;
            if (FFN_I8) transpose_item_i8(src, DFF, 64 * kb, sc, sc < DFF, F.ws + WS_W13 + f * W13_STRIDE, (size_t)np, DMODEL, (const unsigned*)(F.ws + WS_CMAX) + (size_t)((l * 2 + f) * 2 + bj) * DFF, (float*)(F.ws + WS_SW) + f * N13, scr, F.lane);
            else transpose_item(src, DFF, 64 * kb, sc, sc < DFF, (bf16*)(F.ws + WS_W13 + f * W13_STRIDE), (size_t)np, DMODEL, scr, F.lane); continue; }
        r -= 2 * I13;
        if (r < 2 * I2) { const int f = r / I2; r -= f * I2; if (!((parts >> (2 + f)) & 1)) continue; const int kb = r / 32, nb = r % 32;
            const float* src = A.in[10] + (size_t)(l * 2 + f) * DFF * DMODEL;
            transpose_item(src, DMODEL, 64 * kb, 32 * nb, 64 * kb < DFF, (bf16*)(F.ws + WS_W2T + f * W2T_STRIDE), (size_t)(32 * nb), DFFP, scr, F.lane); continue; }
        r -= 2 * I2;
        if (r < IIN) { if (!(parts & 16)) continue; const int kb = r / 72, nb = r % 72, np = 32 * nb; const int nsrc = (np < 768) ? ((np & ~255) + 64 * ((np >> 5) & 3) + 32 * ((np >> 7) & 1)) : np;
            transpose_item(A.in[6] + (size_t)l * DMODEL * INCOLS, INCOLS, 64 * kb, nsrc, true, (bf16*)(F.ws + WS_WIN), (size_t)(32 * nb), DMODEL, scr, F.lane); continue; }
        r -= IIN;
        { if (!(parts & 32)) continue; const int kb = r / 32, nb = r % 32; transpose_item(A.in[7] + (size_t)l * DMODEL * DMODEL, DMODEL, 64 * kb, 32 * nb, true, (bf16*)(F.ws + WS_WOUT), (size_t)(32 * nb), DMODEL, scr, F.lane); }
    }
}
__device__ __forceinline__ void mod_gemv(const Ctx& F, const Args& A) {
    const int gw = F.vcu * NWAVES + F.wave, NGW = F.G * NWAVES;
    const float* c = A.in[1]; const float* wm = A.in[4]; const float* bm = A.in[5]; float* mv = (float*)(F.ws + WS_MVEC);
    for (int it = gw; it < 576; it += NGW) {
        const int l = it / 288, rem = it % 288, nc = rem >> 3, kc = rem & 7; const int n0 = nc * 256 + 4 * F.lane;
        f32x4 a0 = {0.f, 0.f, 0.f, 0.f}, a1 = {0.f, 0.f, 0.f, 0.f};
        const float* wp = wm + ((size_t)l * DMODEL + kc * 128) * MODC + n0;
#pragma unroll 4
        for (int k = 0; k < 128; ++k) { const f32x4 w = *(const f32x4*)(wp + (size_t)k * MODC);
            const float c0 = c[kc * 128 + k], c1 = c[DMODEL + kc * 128 + k];
            const float s0 = c0 / (1.f + __expf(-c0)), s1 = c1 / (1.f + __expf(-c1));
            a0 += w * s0; a1 += w * s1; }
        if (kc == 0) { const f32x4 bv = *(const f32x4*)(bm + (size_t)l * MODC + n0); a0 += bv; a1 += bv; }
        float* d0 = mv + (size_t)(l * 2 + 0) * MODC + n0; float* d1 = mv + (size_t)(l * 2 + 1) * MODC + n0;
#pragma unroll
        for (int e = 0; e < 4; ++e) { unsafeAtomicAdd(d0 + e, a0[e]); unsafeAtomicAdd(d1 + e, a1[e]); }
    }
}
__device__ __forceinline__ void hyena_h3(const Ctx& F, const Args& A) {
    const int gw = F.vcu * NWAVES + F.wave, NGW = F.G * NWAVES; const int j = F.lane;
    const float* w1 = A.in[18]; const float* b1 = A.in[19]; const float* w2 = A.in[20]; const float* b2 = A.in[21]; const float* w3 = A.in[22]; const float* b3 = A.in[23]; const float* fqp = A.in[25];
    float* H3 = (float*)(F.ws + WS_H3);
    const float fq = fqp[j], bb1 = b1[j], bb2 = b2[j], bb3 = b3[j];
    const int fi = (j >= 1 && j <= 32) ? ((j - 1) & 15) : 0; const float fr = 1e-4f + (float)fi * ((15.0f - 1e-4f) / 15.0f);
    for (int l = gw; l < SEQ; l += NGW) {
        const float t = (float)l * (1.0f / 8191.0f); const float w = (float)l * (float)(6.283185307179586 / 8192.0);
        const float arg = fr * w;
        float zv = (j == 0) ? t : (j <= 16 ? cosf(arg) : -sinf(arg));
        float a = bb1;
#pragma unroll
        for (int i = 0; i < 33; ++i) a += __shfl(zv, i) * w1[i * 64 + j];
        const float h1 = sinf(fq * a);
        a = bb2;
#pragma unroll 16
        for (int i = 0; i < 64; ++i) a += __shfl(h1, i) * w2[i * 64 + j];
        const float h2 = sinf(fq * a);
        a = bb3;
#pragma unroll 16
        for (int i = 0; i < 64; ++i) a += __shfl(h2, i) * w3[i * 64 + j];
        H3[(size_t)l * 64 + j] = sinf(fq * a);
    }
}
__device__ __forceinline__ void rope_table(const Ctx& F) {
    float* T = (float*)(F.ws + WS_ROPE);
    for (int idx = (F.vcu * NWAVES + F.wave) * 64 + F.lane; idx < 2048; idx += F.G * NWAVES * 64) { const int pos = idx >> 4, j = idx & 15;
        const float inv = exp2f(-(float)(2 * j) * (1.0f / 32.0f) * 13.287712379549449f); const float ang = (float)pos * inv; T[2 * idx] = cosf(ang); T[2 * idx + 1] = sinf(ang); }
}
__device__ __forceinline__ void norm_phase(const Ctx& F, const Args& A, int l, int i) {
    const int gw = F.vcu * NWAVES + F.wave, NGW = F.G * NWAVES;
    const float* xin = (l == 0 && i == 0) ? A.in[0] : F.out; const float* g = A.in[3] + (size_t)(l * 3 + i) * DMODEL; const float* mv = (const float*)(F.ws + WS_MVEC);
    bf16* XN = (bf16*)(F.ws + WS_XN);
    for (int row = gw; row < MTOK; row += NGW) {
        const int b = row >> 13; const float* sh = mv + (size_t)(l * 2 + b) * MODC + i * 3072; const float* sc = sh + 1024;
        const f32x4* xr = (const f32x4*)(xin + (size_t)row * DMODEL) + F.lane;
        f32x4 v[4]; float s = 0.f;
#pragma unroll
        for (int j = 0; j < 4; ++j) { v[j] = xr[64 * j]; s += (v[j].x * v[j].x + v[j].y * v[j].y) + (v[j].z * v[j].z + v[j].w * v[j].w); }
        const float rstd = rsqrtf(wave_sum(s) * (1.f / DMODEL) + EPS);
        v2u* o8 = (v2u*)(XN + (size_t)row * DMODEL) + F.lane;
        f32x4 y[4]; float am = 0.f;
#pragma unroll
        for (int j = 0; j < 4; ++j) { const f32x4 gg = ((const f32x4*)g)[64 * j + F.lane], ss = ((const f32x4*)sc)[64 * j + F.lane], hh = ((const f32x4*)sh)[64 * j + F.lane];
            y[j] = v[j] * rstd * gg * (ss + 1.0f) + hh; am = __builtin_fmaxf(__builtin_fmaxf(am, __builtin_fmaxf(__builtin_fabsf(y[j].x), __builtin_fabsf(y[j].y))), __builtin_fmaxf(__builtin_fabsf(y[j].z), __builtin_fabsf(y[j].w))); }
        if (FFN_I8 && i != 1) {
#pragma unroll
            for (int o = 1; o < 64; o <<= 1) am = __builtin_fmaxf(am, __shfl_xor(am, o));
            const float inv = am > 0.f ? 127.0f / am : 0.f;
            if (F.lane == 0) ((float*)(F.ws + WS_SA))[row] = am * (1.0f / 127.0f);
#pragma unroll
            for (int j = 0; j < 4; ++j) { if (FFN_I8 == 2) { v2u w; w.x = pk2(__builtin_rintf(inv * y[j].x), __builtin_rintf(inv * y[j].y)); w.y = pk2(__builtin_rintf(inv * y[j].z), __builtin_rintf(inv * y[j].w)); o8[64 * j] = w; }
                else ((unsigned*)((unsigned char*)XN + (size_t)row * DMODEL))[64 * j + F.lane] = pack4_i8(inv * y[j].x, inv * y[j].y, inv * y[j].z, inv * y[j].w); }
        } else {
#pragma unroll
            for (int j = 0; j < 4; ++j) { v2u w; w.x = pk2(y[j].x, y[j].y); w.y = pk2(y[j].z, y[j].w); o8[64 * j] = w; }
        }
    }
}
__device__ __forceinline__ void prep_qk(const Ctx& F, const Args& A, int l) {
    const int gw = F.vcu * NWAVES + F.wave, NGW = F.G * NWAVES;
    const bf16* H = (const bf16*)(F.ws + WS_HID); bf16* QN = (bf16*)(F.ws + WS_QN); bf16* KN = (bf16*)(F.ws + WS_KN);
    const float* qkg = (l == 0) ? A.in[11] : A.in[15];
    const int i = F.lane & 31, hs = F.lane >> 5;
    const float gq0 = qkg[2 * i], gq1 = qkg[2 * i + 1], gk0 = qkg[64 + 2 * i], gk1 = qkg[64 + 2 * i + 1];
    const float inv = exp2f(-(float)(2 * (i & 15)) * (1.0f / 32.0f) * 13.287712379549449f);
    for (int row = gw; row < MTOK; row += NGW) {
        float cs = 1.f, sn = 0.f;
        if (l == 1) { const int t = row & (SEQ - 1); const float pos = (float)((i < 16) ? (t >> 6) : (t & 63)); const float ang = pos * inv; cs = cosf(ang); sn = sinf(ang); }
#pragma unroll
        for (int jj = 0; jj < 5; ++jj) { const int head = 2 * jj + hs;
            const unsigned v = *(const unsigned*)(H + (size_t)row * INCOLS + head * 64 + 2 * i);
            const float x0 = bf_lo(v), x1 = bf_hi(v);
            float ss = x0 * x0 + x1 * x1;
#pragma unroll
            for (int o = 1; o < 32; o <<= 1) ss += __shfl_xor(ss, o);
            const float rstd = rsqrtf(ss * (1.f / 64.f) + EPS);
            const bool isq = head < 8;
            float y0 = x0 * rstd * (isq ? gq0 : gk0), y1 = x1 * rstd * (isq ? gq1 : gk1);
            if (l == 1) { const float r0 = y0 * cs - y1 * sn, r1 = y0 * sn + y1 * cs; y0 = r0; y1 = r1; }
            if (isq) *(unsigned*)(QN + (size_t)row * 512 + head * 64 + 2 * i) = pk2(y0 * att::C2, y1 * att::C2);
            else *(unsigned*)(KN + (size_t)row * 128 + (head - 8) * 64 + 2 * i) = pk2(y0, y1); }
    }
}
__device__ __forceinline__ void ld8(const bf16* p, float (&o)[8]) { const v4u v = *(const v4u*)p; o[0] = bf_lo(v.x); o[1] = bf_hi(v.x); o[2] = bf_lo(v.y); o[3] = bf_hi(v.y); o[4] = bf_lo(v.z); o[5] = bf_hi(v.z); o[6] = bf_lo(v.w); o[7] = bf_hi(v.w); }
__device__ __forceinline__ void ldf8(const float* p, float (&o)[8]) { const f32x4 a = *(const f32x4*)p, b = *(const f32x4*)(p + 4); o[0] = a.x; o[1] = a.y; o[2] = a.z; o[3] = a.w; o[4] = b.x; o[5] = b.y; o[6] = b.z; o[7] = b.w; }
__device__ __forceinline__ void conv_gate_l0(const Ctx& F, const Args& A) {
    const int gw = F.vcu * NWAVES + F.wave, NGW = F.G * NWAVES;
    const bf16* H = (const bf16*)(F.ws + WS_HID) + 768; bf16* MIX = (bf16*)(F.ws + WS_XN);
    const float* cw = A.in[13]; const float* cb = A.in[14]; const int c0 = 8 * F.lane;
    float w0[8], w1[8], w2[8], bb[8]; ldf8(cw + c0, w0); ldf8(cw + 512 + c0, w1); ldf8(cw + 1024 + c0, w2); ldf8(cb + c0, bb);
    for (int it = gw; it < 2048; it += NGW) {
        const int row0 = it * 8, t0 = row0 & (SEQ - 1); const bf16* hp = H + (size_t)row0 * INCOLS + c0;
        float gc[10][8], uu[10][8], gb[8][8];
#pragma unroll
        for (int r = 0; r < 10; ++r) { const bool ok = (t0 + r - 1 >= 0) && (t0 + r - 1 < SEQ); const bf16* p = hp + (long)(r - 1) * INCOLS;
            if (ok) { ld8(p + 512, gc[r]); ld8(p + 1024, uu[r]); } else {
#pragma unroll
                for (int e = 0; e < 8; ++e) { gc[r][e] = 0.f; uu[r][e] = 0.f; } } }
#pragma unroll
        for (int r = 0; r < 8; ++r) ld8(hp + (size_t)r * INCOLS, gb[r]);
#pragma unroll
        for (int r = 0; r < 8; ++r) { float o[8];
#pragma unroll
            for (int e = 0; e < 8; ++e) o[e] = gb[r][e] * (w0[e] * (gc[r][e] * uu[r][e]) + w1[e] * (gc[r + 1][e] * uu[r + 1][e]) + w2[e] * (gc[r + 2][e] * uu[r + 2][e]) + bb[e]);
            v4u w; w.x = pk2(o[0], o[1]); w.y = pk2(o[2], o[3]); w.z = pk2(o[4], o[5]); w.w = pk2(o[6], o[7]);
            *(v4u*)(MIX + (size_t)(row0 + r) * DMODEL + 512 + c0) = w; }
    }
}
constexpr int ZT_LD = 516;
__device__ __forceinline__ void prep_conv_l1(const Ctx& F, const Args& A) {
    const bf16* H = (const bf16*)(F.ws + WS_HID) + 768; float* ZT = (float*)(F.ws + WS_ZT);
    const float* cw = A.in[16]; const float* cb = A.in[17]; const int c0 = 8 * F.lane;
    LAS float* tile = (LAS float*)F.lds;
    float a0[8], a1[8], a2[8], ab[8], v0[8], v1[8], v2[8], vb[8];
    ldf8(cw + 512 + c0, a0); ldf8(cw + 1536 + 512 + c0, a1); ldf8(cw + 3072 + 512 + c0, a2); ldf8(cb + 512 + c0, ab);
    ldf8(cw + 1024 + c0, v0); ldf8(cw + 1536 + 1024 + c0, v1); ldf8(cw + 3072 + 1024 + c0, v2); ldf8(cb + 1024 + c0, vb);
    for (int it = F.vcu; it < 256; it += F.G) {
        const int row0 = it * 64 + F.wave * 8, t0 = row0 & (SEQ - 1); const bf16* hp = H + (size_t)row0 * INCOLS + c0;
        float xa[10][8], xv[10][8];
#pragma unroll
        for (int r = 0; r < 10; ++r) { const bool ok = (t0 + r - 1 >= 0) && (t0 + r - 1 < SEQ); const bf16* p = hp + (long)(r - 1) * INCOLS;
            if (ok) { ld8(p + 512, xa[r]); ld8(p + 1024, xv[r]); } else {
#pragma unroll
                for (int e = 0; e < 8; ++e) { xa[r][e] = 0.f; xv[r][e] = 0.f; } } }
#pragma unroll
        for (int r = 0; r < 8; ++r) { float z[8];
#pragma unroll
            for (int e = 0; e < 8; ++e) z[e] = (a0[e] * xa[r][e] + a1[e] * xa[r + 1][e] + a2[e] * xa[r + 2][e] + ab[e]) * (v0[e] * xv[r][e] + v1[e] * xv[r + 1][e] + v2[e] * xv[r + 2][e] + vb[e]);
            LAS f32x4* tp = (LAS f32x4*)(tile + (F.wave * 8 + r) * ZT_LD + c0); tp[0] = (f32x4){z[0], z[1], z[2], z[3]}; tp[1] = (f32x4){z[4], z[5], z[6], z[7]}; }
        __syncthreads();
        float* zp = ZT + (size_t)(F.wave * 64) * MTOK + it * 64 + F.lane;
#pragma unroll 8
        for (int cc = 0; cc < 64; ++cc) zp[(size_t)cc * MTOK] = tile[F.lane * ZT_LD + F.wave * 64 + cc];
        __syncthreads();
    }
}
__device__ __forceinline__ void post_l1(const Ctx& F, const Args& A) {
    const bf16* H = (const bf16*)(F.ws + WS_HID) + 768; const float* YT = (const float*)(F.ws + WS_ZT); bf16* MIX = (bf16*)(F.ws + WS_XN);
    const float* cw = A.in[16]; const float* cb = A.in[17]; const int c0 = 8 * F.lane;
    LAS float* tile = (LAS float*)F.lds;
    float a0[8], a1[8], a2[8], ab[8];
    ldf8(cw + c0, a0); ldf8(cw + 1536 + c0, a1); ldf8(cw + 3072 + c0, a2); ldf8(cb + c0, ab);
    for (int it = F.vcu; it < 256; it += F.G) {
        const float* yp = YT + (size_t)(F.wave * 64) * MTOK + it * 64 + F.lane;
#pragma unroll 8
        for (int cc = 0; cc < 64; ++cc) tile[F.lane * ZT_LD + F.wave * 64 + cc] = yp[(size_t)cc * MTOK];
        const int row0 = it * 64 + F.wave * 8, t0 = row0 & (SEQ - 1); const bf16* hp = H + (size_t)row0 * INCOLS + c0;
        float xa[10][8];
#pragma unroll
        for (int r = 0; r < 10; ++r) { const bool ok = (t0 + r - 1 >= 0) && (t0 + r - 1 < SEQ); const bf16* p = hp + (long)(r - 1) * INCOLS;
            if (ok) ld8(p, xa[r]); else {
#pragma unroll
                for (int e = 0; e < 8; ++e) xa[r][e] = 0.f; } }
        __syncthreads();
#pragma unroll
        for (int r = 0; r < 8; ++r) { const LAS f32x4* tp = (const LAS f32x4*)(tile + (F.wave * 8 + r) * ZT_LD + c0); const f32x4 y0 = tp[0], y1 = tp[1]; const float yy[8] = {y0.x, y0.y, y0.z, y0.w, y1.x, y1.y, y1.z, y1.w}; float o[8];
#pragma unroll
            for (int e = 0; e < 8; ++e) o[e] = (a0[e] * xa[r][e] + a1[e] * xa[r + 1][e] + a2[e] * xa[r + 2][e] + ab[e]) * yy[e];
            v4u w; w.x = pk2(o[0], o[1]); w.y = pk2(o[2], o[3]); w.z = pk2(o[4], o[5]); w.w = pk2(o[6], o[7]);
            *(v4u*)(MIX + (size_t)(row0 + r) * DMODEL + 512 + c0) = w; }
        __syncthreads();
    }
}
__device__ __forceinline__ void fft_sincos2pi(float f, float& s, float& c) { s = __builtin_amdgcn_sinf(f); c = __builtin_amdgcn_cosf(f); }
#define FFT_HD __device__ __forceinline__
#define FFT_OPAQUE(x) asm volatile("" : "+v"(x))
#define FFT_NOUNROLL _Pragma("unroll 1")
#ifndef FFT_HD
#define FFT_HD static inline
#endif
struct cf { float x, y; };
FFT_HD cf cmk(float x, float y) { cf r; r.x = x; r.y = y; return r; }
FFT_HD cf cadd(cf a, cf b) { return cmk(a.x + b.x, a.y + b.y); }
FFT_HD cf csub(cf a, cf b) { return cmk(a.x - b.x, a.y - b.y); }
FFT_HD cf cmul(cf a, cf b) { return cmk(a.x * b.x - a.y * b.y, a.x * b.y + a.y * b.x); }
FFT_HD cf cmulc(cf a, cf b) { return cmk(a.x * b.x + a.y * b.y, a.y * b.x - a.x * b.y); }
#ifndef FFT_OPAQUE
#define FFT_OPAQUE(x)
#define FFT_NOUNROLL
#endif
#define FFT_PAD(i) ((i) + (((i) >> 6) << 2))
constexpr int FFT_N = 16384;
constexpr int FFT_LDS_ELEMS = FFT_N + (FFT_N >> 6) * 4;

template <bool INV> FFT_HD void dft4(cf& a, cf& b, cf& c, cf& d) {
    const cf s0 = cadd(a, c), s1 = csub(a, c), s2 = cadd(b, d), s3 = csub(b, d);
    a = cadd(s0, s2); c = csub(s0, s2);
    if (!INV) { b = cmk(s1.x + s3.y, s1.y - s3.x); d = cmk(s1.x - s3.y, s1.y + s3.x); }
    else      { b = cmk(s1.x - s3.y, s1.y + s3.x); d = cmk(s1.x + s3.y, s1.y - s3.x); }
}
template <bool INV, int M> FFT_HD cf tw16(cf v) {
    constexpr float C1 = 0.92387953251128674f, S1 = 0.38268343236508977f, R = 0.70710678118654752f;
    float c, s;
    if (M == 0) return v;
    if (M == 1) { c = C1; s = S1; } else if (M == 2) { c = R; s = R; } else if (M == 3) { c = S1; s = C1; }
    else if (M == 4) { c = 0.f; s = 1.f; } else if (M == 6) { c = -R; s = R; } else   { c = -C1; s = -S1; }
    const cf w = cmk(c, INV ? s : -s);
    return cmul(v, w);
}
template <bool INV> FFT_HD void dft16(cf (&r)[16]) {
    dft4<INV>(r[0], r[4], r[8], r[12]); dft4<INV>(r[1], r[5], r[9], r[13]); dft4<INV>(r[2], r[6], r[10], r[14]); dft4<INV>(r[3], r[7], r[11], r[15]);
    r[5] = tw16<INV, 1>(r[5]); r[6] = tw16<INV, 2>(r[6]); r[7] = tw16<INV, 3>(r[7]);
    r[9] = tw16<INV, 2>(r[9]); r[10] = tw16<INV, 4>(r[10]); r[11] = tw16<INV, 6>(r[11]);
    r[13] = tw16<INV, 3>(r[13]); r[14] = tw16<INV, 6>(r[14]); r[15] = tw16<INV, 9>(r[15]);
    dft4<INV>(r[0], r[1], r[2], r[3]); dft4<INV>(r[4], r[5], r[6], r[7]); dft4<INV>(r[8], r[9], r[10], r[11]); dft4<INV>(r[12], r[13], r[14], r[15]);
}
#define FFT_XJ(r, j) r[4 * ((j) & 3) + ((j) >> 2)]

template <bool INV, int PS, class Mem> FFT_HD void r16_butterfly(const Mem& mem, int pb, float frac) {
    cf r[16];
#pragma unroll
    for (int k = 0; k < 16; ++k) r[k] = mem.ld(pb + PS * k);
    float s1, c1; fft_sincos2pi(frac, s1, c1);
    const cf w1 = cmk(c1, INV ? s1 : -s1);
    cf w[16];
    w[1] = w1; w[2] = cmul(w1, w1); w[3] = cmul(w[2], w1); w[4] = cmul(w[2], w[2]); w[5] = cmul(w[4], w1); w[6] = cmul(w[4], w[2]); w[7] = cmul(w[4], w[3]);
    w[8] = cmul(w[4], w[4]); w[9] = cmul(w[8], w1); w[10] = cmul(w[8], w[2]); w[11] = cmul(w[8], w[3]); w[12] = cmul(w[8], w[4]); w[13] = cmul(w[8], w[5]); w[14] = cmul(w[8], w[6]); w[15] = cmul(w[8], w[7]);
    if (INV) {
#pragma unroll
        for (int j = 1; j < 16; ++j) r[j] = cmul(r[j], w[j]);
        dft16<true>(r);
#pragma unroll
        for (int k = 0; k < 16; ++k) mem.st(pb + PS * k, FFT_XJ(r, k));
    } else {
        dft16<false>(r);
#pragma unroll
        for (int j = 0; j < 16; ++j) { cf v = FFT_XJ(r, j); if (j) v = cmul(v, w[j]); mem.st(pb + PS * j, v); }
    }
}
template <bool INV, class Mem> FFT_HD void r4_butterfly(const Mem& mem, int id) {
    const int pb = FFT_PAD(4 * id);
    cf a = mem.ld(pb), b = mem.ld(pb + 1), c = mem.ld(pb + 2), d = mem.ld(pb + 3);
    dft4<INV>(a, b, c, d);
    mem.st(pb, a); mem.st(pb + 1, b); mem.st(pb + 2, c); mem.st(pb + 3, d);
}
template <int P, class Mem> FFT_HD void fft_fwd_pass(const Mem& mem, int tid) {
    FFT_OPAQUE(tid);
    if (P == 0) { FFT_NOUNROLL for (int i = 0; i < 2; ++i) { const int id = tid + 512 * i; r16_butterfly<false, 1088>(mem, FFT_PAD(id), (float)id * (1.0f / 16384.0f)); } }
    else if (P == 1) { FFT_NOUNROLL for (int i = 0; i < 2; ++i) { const int id = tid + 512 * i, blk = id >> 6, n = id & 63; r16_butterfly<false, 68>(mem, FFT_PAD(blk * 1024 + n), (float)n * (1.0f / 1024.0f)); } }
    else if (P == 2) { FFT_NOUNROLL for (int i = 0; i < 2; ++i) { const int id = tid + 512 * i, blk = id >> 2, n = id & 3; r16_butterfly<false, 4>(mem, FFT_PAD(blk * 64 + n), (float)n * (1.0f / 64.0f)); } }
    else { FFT_NOUNROLL for (int i = 0; i < 8; ++i) r4_butterfly<false>(mem, tid + 512 * i); }
}
template <int P, class Mem> FFT_HD void fft_inv_pass(const Mem& mem, int tid) {
    FFT_OPAQUE(tid);
    if (P == 0) { FFT_NOUNROLL for (int i = 0; i < 8; ++i) r4_butterfly<true>(mem, tid + 512 * i); }
    else if (P == 1) { FFT_NOUNROLL for (int i = 0; i < 2; ++i) { const int id = tid + 512 * i, blk = id >> 2, n = id & 3; r16_butterfly<true, 4>(mem, FFT_PAD(blk * 64 + n), (float)n * (1.0f / 64.0f)); } }
    else if (P == 2) { FFT_NOUNROLL for (int i = 0; i < 2; ++i) { const int id = tid + 512 * i, blk = id >> 6, n = id & 63; r16_butterfly<true, 68>(mem, FFT_PAD(blk * 1024 + n), (float)n * (1.0f / 1024.0f)); } }
    else { FFT_NOUNROLL for (int i = 0; i < 2; ++i) { const int id = tid + 512 * i; r16_butterfly<true, 1088>(mem, FFT_PAD(id), (float)id * (1.0f / 16384.0f)); } }
}

struct LdsMem { LAS f32x2* p; __device__ __forceinline__ cf ld(int i) const { const f32x2 v = p[i]; return cmk(v.x, v.y); } __device__ __forceinline__ void st(int i, cf v) const { p[i] = (f32x2){v.x, v.y}; } };
#define WG_BAR() do { asm volatile("s_waitcnt vmcnt(0) lgkmcnt(0)" ::: "memory"); __builtin_amdgcn_s_barrier(); asm volatile("" ::: "memory"); } while (0)
__device__ __forceinline__ void fft_forward(const LdsMem& mem, int tid) {
    fft_fwd_pass<0>(mem, tid); WG_BAR(); fft_fwd_pass<1>(mem, tid); WG_BAR(); fft_fwd_pass<2>(mem, tid); WG_BAR(); fft_fwd_pass<3>(mem, tid); WG_BAR();
}
__device__ __forceinline__ void fft_inverse(const LdsMem& mem, int tid) {
    fft_inv_pass<0>(mem, tid); WG_BAR(); fft_inv_pass<1>(mem, tid); WG_BAR(); fft_inv_pass<2>(mem, tid); WG_BAR(); fft_inv_pass<3>(mem, tid); WG_BAR();
}
__device__ __forceinline__ void hyena_taps_gemm(const Ctx& F, const Args& A) {
    typedef float f32x16 __attribute__((ext_vector_type(16)));
    const float* H3 = (const float*)(F.ws + WS_H3); const float* w4 = A.in[24]; float* HfT = (float*)(F.ws + WS_ZT);
    LAS float* wl = (LAS float*)F.lds;
    const int j = F.lane & 31, h = F.lane >> 5;
    for (int it = F.vcu; it < 256; it += F.G) {
        const int cgrp = it & 7, lag0 = ((it >> 3) * 8 + F.wave) * 32; const int lag = lag0 + j;
#pragma unroll
        for (int i = 0; i < 4; ++i) { const int q = F.tid + 512 * i, k = q >> 5, c4 = q & 31; *(LAS f32x4*)(wl + k * 128 + c4 * 4) = *(const f32x4*)(w4 + (size_t)k * 1024 + cgrp * 128 + c4 * 4); }
        const f32x4* hrow = (const f32x4*)(H3 + (size_t)lag * 64);
        float bv[32];
#pragma unroll
        for (int i = 0; i < 16; ++i) { const f32x4 q = hrow[i]; bv[2 * i] = h ? q.y : q.x; bv[2 * i + 1] = h ? q.w : q.z; }
        const float t = (float)lag * (1.0f / 8191.0f);
        __syncthreads();
#pragma unroll 1
        for (int ct = 0; ct < 4; ++ct) { const int ch0 = cgrp * 128 + ct * 32;
            f32x16 acc = {};
            const LAS float* wp = wl + h * 128 + ct * 32 + j;
#pragma unroll
            for (int s = 0; s < 32; ++s) acc = __builtin_amdgcn_mfma_f32_32x32x2f32(wp[s * 256], bv[s], acc, 0, 0, 0);
#pragma unroll
            for (int r = 0; r < 16; ++r) { const int ch = ch0 + (r & 3) + 8 * (r >> 2) + 4 * h; const int c = ch & 511;
                const float dl = 15.350567286626973f - (float)c * (12.280453829301578f / 511.0f);
                float v = acc[r] * __expf(-t * dl); if (ch >= 512 && lag == 0) v = 0.f;
                HfT[(size_t)ch * SEQ + lag] = v; }
        }
        __syncthreads();
    }
}
__device__ __forceinline__ void hyena_filter_item(const Ctx& F, const Args& A, int c) {
    const float* HfT = (const float*)(F.ws + WS_ZT); cf* KF = (cf*)(F.ws + WS_KF) + (size_t)c * FFT_N;
    LdsMem mem; mem.p = (LAS f32x2*)F.lds;
    LAS float* red = (LAS float*)(F.lds + MISC_OFF + 256);
    const int tid = F.tid;
    f32x4 hf[4], hb[4];
#pragma unroll
    for (int i = 0; i < 4; ++i) { const int l0 = 4 * (tid + 512 * i); hf[i] = *(const f32x4*)(HfT + (size_t)c * SEQ + l0); hb[i] = *(const f32x4*)(HfT + (size_t)(512 + c) * SEQ + l0); }
    float ss = 0.f;
#pragma unroll
    for (int i = 0; i < 4; ++i) { const int l0 = 4 * (tid + 512 * i);
#pragma unroll
        for (int e = 0; e < 4; ++e) { const int l = l0 + e; const float a = hf[i][e], b = hb[i][e]; ss += a * a + b * b;
            mem.st(FFT_PAD(l), cmk(a, 0.f)); mem.st(FFT_PAD(l > 0 ? FFT_N - l : 8192), cmk(b, 0.f)); } }
    ss = wave_sum(ss);
    if (F.lane == 0) red[F.wave] = ss;
    WG_BAR();
    float tot = 0.f;
#pragma unroll
    for (int w = 0; w < 8; ++w) tot += red[w];
    const float sc = rsqrtf(tot + EPS) * (1.0f / 16384.0f);
    fft_forward(mem, tid);
#pragma unroll
    for (int i = 0; i < 16; ++i) { const int p = 2 * (tid + 512 * i); const cf v0 = mem.ld(FFT_PAD(p)), v1 = mem.ld(FFT_PAD(p) + 1); *(f32x4*)(KF + p) = (f32x4){v0.x * sc, v0.y * sc, v1.x * sc, v1.y * sc}; }
    WG_BAR();
}
__device__ __forceinline__ void hyena_conv_item(const Ctx& F, const Args& A, int c) {
    float* ZT = (float*)(F.ws + WS_ZT) + (size_t)c * MTOK; const cf* KF = (const cf*)(F.ws + WS_KF) + (size_t)c * FFT_N; const float skip = A.in[26][c];
    LdsMem mem; mem.p = (LAS f32x2*)F.lds; const int tid = F.tid;
    {   f32x4 za[4], zb[4];
#pragma unroll
        for (int i = 0; i < 4; ++i) { const int t0 = 4 * (tid + 512 * i); za[i] = *(const f32x4*)(ZT + t0); zb[i] = *(const f32x4*)(ZT + SEQ + t0); }
#pragma unroll
        for (int i = 0; i < 4; ++i) { const int t0 = 4 * (tid + 512 * i);
#pragma unroll
            for (int e = 0; e < 4; ++e) { mem.st(FFT_PAD(t0 + e), cmk(za[i][e], zb[i][e])); mem.st(FFT_PAD(SEQ + t0 + e), cmk(0.f, 0.f)); } } }
    WG_BAR();
    fft_fwd_pass<0>(mem, tid); WG_BAR(); fft_fwd_pass<1>(mem, tid); WG_BAR(); fft_fwd_pass<2>(mem, tid); WG_BAR();
    {   f32x4 kf[16];
#pragma unroll
        for (int i = 0; i < 16; ++i) kf[i] = *(const f32x4*)(KF + 2 * (tid + 512 * i));
        fft_fwd_pass<3>(mem, tid); WG_BAR();
#pragma unroll
        for (int i = 0; i < 16; ++i) { const int pp = FFT_PAD(2 * (tid + 512 * i)); const cf v0 = mem.ld(pp), v1 = mem.ld(pp + 1);
            mem.st(pp, cmul(v0, cmk(kf[i].x, kf[i].y))); mem.st(pp + 1, cmul(v1, cmk(kf[i].z, kf[i].w))); } }
    WG_BAR();
    fft_inv_pass<0>(mem, tid); WG_BAR(); fft_inv_pass<1>(mem, tid); WG_BAR(); fft_inv_pass<2>(mem, tid); WG_BAR();
    {   f32x4 za[4], zb[4];
#pragma unroll
        for (int i = 0; i < 4; ++i) { const int t0 = 4 * (tid + 512 * i); za[i] = *(const f32x4*)(ZT + t0); zb[i] = *(const f32x4*)(ZT + SEQ + t0); }
        fft_inv_pass<3>(mem, tid); WG_BAR();
#pragma unroll
        for (int i = 0; i < 4; ++i) { const int t0 = 4 * (tid + 512 * i); f32x4 o0, o1;
#pragma unroll
            for (int e = 0; e < 4; ++e) { const cf v = mem.ld(FFT_PAD(t0 + e)); o0[e] = v.x + skip * za[i][e]; o1[e] = v.y + skip * zb[i][e]; }
            *(f32x4*)(ZT + t0) = o0; *(f32x4*)(ZT + SEQ + t0) = o1; } }
    WG_BAR();
}
#ifndef DUP_S
#define DUP_S (-1)
#endif
#ifndef DUP_L
#define DUP_L (-1)
#endif
#ifndef DUP_PART
#define DUP_PART 3
#endif
#ifndef CONV_IN_L0
#define CONV_IN_L0 0
#endif
#ifndef FORCE8
#define FORCE8 0
#endif
#ifndef XBAR
#define XBAR 0
#endif
#ifndef PH_MASK
#define PH_MASK 0xFFFF
#endif
constexpr int NPHASE = 25;
__global__ void __launch_bounds__(NTHR, 2) mk_fwd(Args args) {
    extern __shared__ __attribute__((aligned(16))) unsigned char lds_raw[];
    Ctx F;
    F.lds = (LAS unsigned char*)lds_raw;
    F.tid = threadIdx.x; F.lane = F.tid & 63; F.wave = __builtin_amdgcn_readfirstlane(F.tid >> 6);
    F.G = gridDim.x; { const int bx = blockIdx.x; F.vcu = (F.G % 8 == 0) ? (bx % 8) * (F.G / 8) + bx / 8 : bx; }
    F.out = args.out; F.ws = args.ws;
    volatile LAS unsigned* MISC = (volatile LAS unsigned*)(F.lds + MISC_OFF);
    for (int u = F.tid; u < 64; u += NTHR) MISC[u] = 0u;
    __syncthreads();
    const int lo = args.ph_lo, hi = args.ph_hi;
    const bool multi = (hi - lo) > 1;
    XcdBarrier bar; bar.bar = (unsigned*)(F.ws + WS_CTL) + CW_BAR; bar.x = 0; bar.st = nullptr;
    if (multi) bar = xcd_barrier_post((unsigned*)(F.ws + WS_CTL) + CW_BAR, MISC + 8);
    if (args.use_cg) cooperative_groups::this_grid().sync();
    const Ctx F0 = F;
    for (int pp = lo * 2; pp < hi * 2; ++pp) {
        const int p = pp >> 1; const int rep = pp & 1;
        if (p == 8 || p == 6) continue;
        const bool dup = (p > 0) && ((p - 1) % 12 == DUP_S) && (DUP_L < 0 || (p - 1) / 12 == DUP_L); if (rep == 1 && !dup) continue;
        const __attribute__((address_space(4))) Args* ap = (const __attribute__((address_space(4))) Args*)__builtin_amdgcn_kernarg_segment_ptr(); asm volatile("" : "+s"(ap)); const Args& A = *(const Args*)ap;
        Ctx F = F0; F.tid = threadIdx.x; asm volatile("" : "+v"(F.tid)); asm volatile("" : "+s"(F.vcu)); asm volatile("" : "+s"(F.G)); asm volatile("" : "+s"(F.out)); asm volatile("" : "+s"(F.ws)); F.lane = F.tid & 63; F.wave = __builtin_amdgcn_readfirstlane(F.tid >> 6);
        if (p == 0) { if constexpr ((PH_MASK & 1) != 0) { convert_weights(F, A, 0, FFN_I8 ? 60 : 63); if (FFN_I8) w13_colmax(F, A); mod_gemv(F, A); hyena_h3(F, A); rope_table(F); } }
        else {
            const int l = (p - 1) / 12, s = (p - 1) % 12;
            const float* mv = uni_ptr((const float*)(F.ws + WS_MVEC) + (size_t)l * 2 * MODC);
            if (s == 0 || s == 3 || s == 9) { if constexpr ((PH_MASK & 2) != 0) { if (s == 0 && l == 0) { hyena_taps_gemm(F, A); if (FFN_I8) { __syncthreads(); convert_weights(F, A, 0, 3); } } norm_phase(F, A, l, s / 3 > 2 ? 2 : s / 3); } }
            else if (s == 1 || s == 10 || s == 2 || s == 11 || s == 8 || s == 4) { if constexpr ((PH_MASK & 4) != 0) {
                pg8::Gemm g; pg8::EpiAny E; E.kind = 0; E.eb = pg8::EpiInproj{nullptr, nullptr, nullptr, nullptr, nullptr, 0.f}; E.es = pg8::EpiSwiglu{nullptr, 0, 0, nullptr, nullptr}; bool i8 = false; E.er = pg8::EpiRes{nullptr, nullptr, 0, nullptr, 0, 0.f};
                if (s == 1 || s == 10) { const int f = s == 10; g = pg8::Gemm{(const bf16*)(F.ws + WS_XN), (const bf16*)(F.ws + WS_W13 + f * W13_STRIDE), MTOK, N13, FFN_I8 == 1 ? DMODEL / 2 : DMODEL}; E.kind = 1; E.es = pg8::EpiSwiglu{(bf16*)(F.ws + WS_HID), DFFP, FFN_I8, (const float*)(F.ws + WS_SA), (const float*)(F.ws + WS_SW) + f * N13}; i8 = FFN_I8 == 1; }
                else if (s == 4) { g = pg8::Gemm{(const bf16*)(F.ws + WS_XN), (const bf16*)(F.ws + WS_WIN), MTOK, INCOLS, DMODEL}; E.kind = 0; E.eb = pg8::EpiInproj{(bf16*)(F.ws + WS_HID), (bf16*)(F.ws + WS_QN), (bf16*)(F.ws + WS_KN), l == 0 ? A.in[11] : A.in[15], l == 1 ? (const float*)(F.ws + WS_ROPE) : nullptr, att::C2}; }
                else if (s == 8) { g = pg8::Gemm{(const bf16*)(F.ws + WS_XN), (const bf16*)(F.ws + WS_WOUT), MTOK, DMODEL, DMODEL}; E.kind = 2; E.er = pg8::EpiRes{F.out, rep ? (float*)(F.ws + WS_HID) : F.out, DMODEL, mv + 1 * 3072 + 2048, MODC, 1.0f}; }
                else { const int f = s == 11; g = pg8::Gemm{(const bf16*)(F.ws + WS_HID), (const bf16*)(F.ws + WS_W2T + f * W2T_STRIDE), MTOK, DMODEL, DFFP}; E.kind = 2;
                    E.er = pg8::EpiRes{(l == 0 && f == 0) ? A.in[0] : F.out, rep ? (float*)(F.ws + WS_KF) : F.out, DMODEL, mv + (f ? 2 : 0) * 3072 + 2048, MODC, 0.5f}; }
                g.A = uni_ptr(g.A); g.Bt = uni_ptr(g.Bt); g.N = uni_i(g.N); g.K = uni_i(g.K); E.kind = uni_i(E.kind);
                E.eb.H = uni_ptr(E.eb.H); E.eb.QN = uni_ptr(E.eb.QN); E.eb.KN = uni_ptr(E.eb.KN); E.eb.qkg = uni_ptr(E.eb.qkg); E.eb.rope = uni_ptr(E.eb.rope); E.es.O = uni_ptr(E.es.O); E.es.ldc = uni_i(E.es.ldc); E.es.sA = uni_ptr(E.es.sA); E.es.sW = uni_ptr(E.es.sW);
                E.er.base = uni_ptr(E.er.base); E.er.out = uni_ptr(E.er.out); E.er.gate = uni_ptr(E.er.gate); E.er.ldc = uni_i(E.er.ldc); E.er.gstride = uni_i(E.er.gstride);
                pg8::StaticOrder S; S.init(MTOK, g.N, F.G, (int)blockIdx.x);
                if (i8) pg8::gemm_phase<pg8::EpiAny, pg8::StaticOrder, true, true, true>(F.lds, g, S, E); else pg8::gemm_phase<pg8::EpiAny, pg8::StaticOrder, true, true, false>(F.lds, g, S, E); } }
            else if (s == 5) { if constexpr ((PH_MASK & 32) != 0) { prep_conv_l1(F, A); __syncthreads(); convert_weights(F, A, 1, 42); } }
            else if (s == 6) { if constexpr ((PH_MASK & 64) != 0) {
                const bf16* QN = (const bf16*)(F.ws + WS_QN); const bf16* KN = (const bf16*)(F.ws + WS_KN); const bf16* V = (const bf16*)(F.ws + WS_HID) + 640; bf16* MIX = (bf16*)(F.ws + WS_XN);
                if constexpr ((PH_MASK & 256) != 0) if (rep == 0 || (DUP_PART & 1))
#pragma unroll 1
                for (int i = 0; i < 2; ++i) { const int u = F.vcu * 2 + i, bh = u >> 5, qb = u & 31, b = bh >> 3, h = bh & 7;
                    if (l == 0) att::attn_unit(true, b, h, qb, QN, KN, V, MIX, (att::lds_ptr)F.lds, A.in[2], A.in[12][h] * att::LOG2E);
                    else attf::attn_unit<8>(b, h, qb, (const attf::bf16*)QN, (const attf::bf16*)KN, (const attf::bf16*)V, (attf::bf16*)MIX, (char*)F.lds); }
                if constexpr ((PH_MASK & 512) != 0) if (l == 0 && (rep == 0 || (DUP_PART & 2))) {
                    conv_gate_l0(F, A);
#pragma unroll 1
                    for (int k = 0; k < 2; ++k) hyena_filter_item(F, A, F.vcu + 256 * k);
                    convert_weights(F, A, 1, 21); }
                if constexpr ((PH_MASK & 1024) != 0) if ((l == 1 || CONV_IN_L0) && rep == 0) {
#pragma unroll 1
                    for (int k = 0; k < 2; ++k) hyena_conv_item(F, A, F.vcu + 256 * k); } } }
            else if (s == 7) { if constexpr ((PH_MASK & 128) != 0) { post_l1(F, A); } }
        }
        for (int xb = 0; xb < XBAR; ++xb) { XcdBarrier b3 = bar; asm volatile("" : "+s"(b3.bar)); asm volatile("" : "+s"(b3.x)); xcd_barrier(b3); }
        if (p + 1 < hi || (rep == 0 && dup)) { XcdBarrier b2 = bar; asm volatile("" : "+s"(b2.bar)); asm volatile("" : "+s"(b2.x)); xcd_barrier(b2); }
    }
}

extern "C" void kernel_launch(void* const* d_in, const int* in_sizes, int n_in, void* d_out, int out_size, void* d_ws, size_t ws_size, hipStream_t stream) {
    static int grid = 0;
    if (grid == 0) {
        if (n_in != 27 || out_size != MTOK * DMODEL || ws_size < WS_END) { fprintf(stderr, "kernel_launch: unexpected problem (n_in %d, out %d, ws %zu)\n", n_in, out_size, ws_size); grid = -1; return; }
        int dev = 0, cus = 0, per_cu = 0;
        if (hipGetDevice(&dev) != hipSuccess || hipDeviceGetAttribute(&cus, hipDeviceAttributeMultiprocessorCount, dev) != hipSuccess) { grid = -1; return; }
        if (hipFuncSetAttribute((const void*)mk_fwd, hipFuncAttributeMaxDynamicSharedMemorySize, LDS_BYTES) != hipSuccess) { fprintf(stderr, "kernel_launch: hipFuncSetAttribute failed\n"); grid = -1; return; }
        if (hipOccupancyMaxActiveBlocksPerMultiprocessor(&per_cu, (const void*)mk_fwd, NTHR, LDS_BYTES) != hipSuccess || per_cu < 1) { fprintf(stderr, "kernel_launch: occupancy query says %d blocks per CU\n", per_cu); per_cu = 1; }
        (void)hipGetLastError();
        grid = cus;
        if (grid != 256) fprintf(stderr, "kernel_launch: %d CUs (tuned for 256)\n", grid);
    }
    if (grid < 0) return;
    (void)hipMemsetAsync((char*)d_ws + WS_CTL, 0, CTL_ZERO_BYTES, stream);
    Args a{};
    for (int i = 0; i < 27; ++i) a.in[i] = (const float*)d_in[i];
    a.out = (float*)d_out; a.ws = (unsigned char*)d_ws; a.use_cg = 0; a.pad = 0;
#if MK_SINGLE
    a.ph_lo = 0; a.ph_hi = NPHASE;
    void* kargs[] = {&a};
    hipError_t e = hipLaunchCooperativeKernel((const void*)mk_fwd, dim3(grid), dim3(NTHR), kargs, LDS_BYTES, stream);
    if (e != hipSuccess) fprintf(stderr, "cooperative launch failed: %s (grid %d)\n", hipGetErrorString(e), grid);
#else
    for (int p = 0; p < NPHASE; ++p) { if (p == 8 || p == 6) continue; a.ph_lo = p; a.ph_hi = p + 1; hipLaunchKernelGGL(mk_fwd, dim3(grid), dim3(NTHR), LDS_BYTES, stream, a); }
#endif
}
```
